# Optimizing an MI355X kernel written in HIP

```python
import math
import jax, jax.numpy as jnp
from jax import lax
import numpy as np

D_MODEL = 2048
BATCH = 2
SEQ = 4096
DEPTH = 4

HEAD_DIM = 64
MIX_WIDTH = D_MODEL
NSA_HEADS = MIX_WIDTH // 2 // HEAD_DIM
NSA_KV_HEADS = NSA_HEADS // 4
NSA_GROUP = NSA_HEADS // NSA_KV_HEADS
SWA_HEADS = (MIX_WIDTH - NSA_HEADS * HEAD_DIM) // HEAD_DIM
SWA_KV_HEADS = SWA_HEADS // 8
SWA_GROUP = SWA_HEADS // SWA_KV_HEADS
CMP_LEN = 32
CMP_STRIDE = 16
CMP_HIDDEN = 4 * HEAD_DIM
SEL_BLOCK = 64
N_SEL = 16
NSA_WINDOW = 512
SWA_WINDOW = 128
NUM_BUCKETS = 32
REL_MAX_DISTANCE = 1024
N_BIAS_HEADS = NSA_HEADS + SWA_HEADS
D_FF = -(-8 * D_MODEL // (3 * 256)) * 256
QBLOCK = 128
RMS_EPS = 1e-5
NEG_INF = -1e30
FORCE_SCORE = 1e6

SPLIT_SIZES = (
    NSA_HEADS * HEAD_DIM,
    NSA_KV_HEADS * HEAD_DIM, NSA_KV_HEADS * HEAD_DIM,
    NSA_KV_HEADS * HEAD_DIM, NSA_KV_HEADS * HEAD_DIM,
    NSA_KV_HEADS * HEAD_DIM, NSA_KV_HEADS * HEAD_DIM,
    NSA_HEADS * 3,
    SWA_HEADS * HEAD_DIM,
    SWA_KV_HEADS * HEAD_DIM, SWA_KV_HEADS * HEAD_DIM,
)
PROJ_WIDTH = sum(SPLIT_SIZES)

kernel_name = "hybrid_nsa_swa_sink_t5bias_swiglu"


def rms_norm(x, g):
    xf = x.astype(jnp.float32)
    y = xf * lax.rsqrt(jnp.mean(xf * xf, axis=-1, keepdims=True) + RMS_EPS)
    return (y * g.astype(jnp.float32)).astype(x.dtype)


def t5_bucket(dist):
    dist = jnp.maximum(dist, 0)
    max_exact = NUM_BUCKETS // 2
    d = jnp.maximum(dist, 1).astype(jnp.float32)
    ratio = jnp.log(d / max_exact) / math.log(REL_MAX_DISTANCE / max_exact)
    large = max_exact + (ratio * (NUM_BUCKETS - max_exact)).astype(jnp.int32)
    large = jnp.minimum(large, NUM_BUCKETS - 1)
    return jnp.where(dist < max_exact, dist, large)


def masked_softmax(s, mask):
    s = jnp.where(mask, s, NEG_INF)
    p = jax.nn.softmax(s, axis=-1)
    return jnp.where(mask, p, 0.0)


def split_columns(proj):
    parts, off = [], 0
    for size in SPLIT_SIZES:
        parts.append(proj[..., off:off + size])
        off += size
    return parts


def to_heads(t, n_heads):
    return t.reshape(t.shape[0], t.shape[1], n_heads, HEAD_DIM)


def compress(kv, pos_emb, w1, w2):
    b, t, hkv, dh = kv.shape
    n_cmp = (t - CMP_LEN) // CMP_STRIDE + 1
    idx = jnp.arange(n_cmp)[:, None] * CMP_STRIDE + jnp.arange(CMP_LEN)[None, :]
    blocks = kv[:, idx] + pos_emb[:, None, :]
    flat = blocks.transpose(0, 1, 3, 2, 4).reshape(b, n_cmp, hkv, CMP_LEN * dh)
    return jax.nn.gelu(flat @ w1) @ w2


def nsa_attention(q, k_c, v_c, k_s, v_s, k_w, v_w, gates, tbl,
                  pos_k, pos_v, ck1, ck2, cv1, cv2):
    b, t = q.shape[0], q.shape[1]
    hkv, grp, dh = NSA_KV_HEADS, NSA_GROUP, HEAD_DIM
    scale = dh ** -0.5
    kc = compress(k_c, pos_k, ck1, ck2)
    vc = compress(v_c, pos_v, cv1, cv2)
    n_cmp = kc.shape[1]
    n_blk = t // SEL_BLOCK
    n_sel = min(N_SEL, n_blk)
    c_end = jnp.arange(n_cmp) * CMP_STRIDE + CMP_LEN - 1
    ci = jnp.arange(n_cmp)[:, None] * CMP_STRIDE
    sj = jnp.arange(n_blk)[None, :] * SEL_BLOCK
    overlap = ((ci < sj + SEL_BLOCK) & (ci + CMP_LEN > sj)).astype(jnp.float32)
    ks_blocks = k_s.reshape(b, n_blk, SEL_BLOCK, hkv, dh).transpose(0, 3, 1, 2, 4)
    vs_blocks = v_s.reshape(b, n_blk, SEL_BLOCK, hkv, dh).transpose(0, 3, 1, 2, 4)
    kwp = jnp.pad(k_w, ((0, 0), (NSA_WINDOW, 0), (0, 0), (0, 0)))
    vwp = jnp.pad(v_w, ((0, 0), (NSA_WINDOW, 0), (0, 0), (0, 0)))
    tbl_g = tbl.reshape(NUM_BUCKETS, hkv, grp)
    tbl_h = tbl_g.transpose(1, 2, 0).astype(jnp.float32)
    b_i = jnp.arange(b)[:, None, None, None]
    h_i = jnp.arange(hkv)[None, :, None, None]
    blk_ids = jnp.arange(n_blk)

    def block(qb):
        t0 = qb * QBLOCK
        tq = t0 + jnp.arange(QBLOCK)
        qblk = lax.dynamic_slice_in_dim(q, t0, QBLOCK, 1).reshape(b, QBLOCK, hkv, grp, dh)
        gblk = lax.dynamic_slice_in_dim(gates, t0, QBLOCK, 1).reshape(b, QBLOCK, hkv, grp, 3)

        dist_c = tq[:, None] - c_end[None, :]
        s_c = jnp.einsum('bqhgd,bchd->bhgqc', qblk, kc).astype(jnp.float32) * scale
        s_c = s_c + tbl_g[t5_bucket(dist_c)].transpose(2, 3, 0, 1).astype(jnp.float32)
        p_c = masked_softmax(s_c, dist_c >= 0)
        o_c = jnp.einsum('bhgqc,bchd->bqhgd', p_c.astype(vc.dtype), vc)

        imp = jnp.einsum('bhgqc,cs->bhqs', p_c, overlap)
        blk_t = tq // SEL_BLOCK
        forced = ((blk_ids[None, :] == 0) | (blk_ids[None, :] == blk_t[:, None])
                  | (blk_ids[None, :] == blk_t[:, None] - 1))
        imp = jnp.where(forced, imp + FORCE_SCORE, imp)
        imp = jnp.where(blk_ids[None, :] > blk_t[:, None], NEG_INF, imp)
        _, top = lax.top_k(imp, n_sel)
        n_tok = n_sel * SEL_BLOCK
        kg = ks_blocks[b_i, h_i, top].reshape(b, hkv, QBLOCK, n_tok, dh)
        vg = vs_blocks[b_i, h_i, top].reshape(b, hkv, QBLOCK, n_tok, dh)
        pos_s = (top[..., None] * SEL_BLOCK + jnp.arange(SEL_BLOCK)).reshape(b, hkv, QBLOCK, n_tok)
        dist_s = tq[None, None, :, None] - pos_s
        s_s = jnp.einsum('bqhgd,bhqkd->bhgqk', qblk, kg).astype(jnp.float32) * scale
        bias_s = tbl_h[jnp.arange(hkv)[None, :, None, None, None],
                       jnp.arange(grp)[None, None, :, None, None],
                       t5_bucket(dist_s)[:, :, None]]
        p_s = masked_softmax(s_s + bias_s, (dist_s >= 0)[:, :, None])
        o_s = jnp.einsum('bhgqk,bhqkd->bqhgd', p_s.astype(vg.dtype), vg)

        kwin = lax.dynamic_slice_in_dim(kwp, t0, QBLOCK + NSA_WINDOW, 1)
        vwin = lax.dynamic_slice_in_dim(vwp, t0, QBLOCK + NSA_WINDOW, 1)
        pos_w = t0 - NSA_WINDOW + jnp.arange(QBLOCK + NSA_WINDOW)
        dist_w = tq[:, None] - pos_w[None, :]
        mask_w = (dist_w >= 0) & (dist_w < NSA_WINDOW) & (pos_w[None, :] >= 0)
        s_w = jnp.einsum('bqhgd,bkhd->bhgqk', qblk, kwin).astype(jnp.float32) * scale
        s_w = s_w + tbl_g[t5_bucket(dist_w)].transpose(2, 3, 0, 1).astype(jnp.float32)
        p_w = masked_softmax(s_w, mask_w)
        o_w = jnp.einsum('bhgqk,bkhd->bqhgd', p_w.astype(vwin.dtype), vwin)

        o = gblk[..., 0:1] * o_c + gblk[..., 1:2] * o_s + gblk[..., 2:3] * o_w
        return o.reshape(b, QBLOCK, hkv * grp * dh)

    out = lax.map(block, jnp.arange(t // QBLOCK))
    return out.transpose(1, 0, 2, 3).reshape(b, t, -1)


def swa_sink_attention(q, k, v, sinks, tbl):
    b, t = q.shape[0], q.shape[1]
    hkv, grp, dh = SWA_KV_HEADS, SWA_GROUP, HEAD_DIM
    scale = dh ** -0.5
    kp = jnp.pad(k, ((0, 0), (SWA_WINDOW, 0), (0, 0), (0, 0)))
    vp = jnp.pad(v, ((0, 0), (SWA_WINDOW, 0), (0, 0), (0, 0)))
    tbl_g = tbl.reshape(NUM_BUCKETS, hkv, grp)
    sink = sinks.reshape(hkv, grp)[None, :, :, None, None].astype(jnp.float32)

    def block(qb):
        t0 = qb * QBLOCK
        tq = t0 + jnp.arange(QBLOCK)
        qblk = lax.dynamic_slice_in_dim(q, t0, QBLOCK, 1).reshape(b, QBLOCK, hkv, grp, dh)
        kwin = lax.dynamic_slice_in_dim(kp, t0, QBLOCK + SWA_WINDOW, 1)
        vwin = lax.dynamic_slice_in_dim(vp, t0, QBLOCK + SWA_WINDOW, 1)
        pos = t0 - SWA_WINDOW + jnp.arange(QBLOCK + SWA_WINDOW)
        dist = tq[:, None] - pos[None, :]
        mask = (dist >= 0) & (dist < SWA_WINDOW) & (pos[None, :] >= 0)
        s = jnp.einsum('bqhgd,bkhd->bhgqk', qblk, kwin).astype(jnp.float32) * scale
        s = s + tbl_g[t5_bucket(dist)].transpose(2, 3, 0, 1).astype(jnp.float32)
        s = jnp.where(mask, s, NEG_INF)
        m = jnp.maximum(jnp.max(s, axis=-1, keepdims=True), sink)
        e = jnp.exp(s - m)
        p = e / (jnp.sum(e, axis=-1, keepdims=True) + jnp.exp(sink - m))
        o = jnp.einsum('bhgqk,bkhd->bqhgd', p.astype(vwin.dtype), vwin)
        return o.reshape(b, QBLOCK, hkv * grp * dh)

    out = lax.map(block, jnp.arange(t // QBLOCK))
    return out.transpose(1, 0, 2, 3).reshape(b, t, -1)


def setup_inputs(seed: int = 0) -> dict:
    key = jax.random.key(seed)
    ks = jax.random.split(key, 18)
    f32 = jnp.float32
    nrm = lambda k, shape, s: jax.random.normal(k, shape, f32) * s
    return {
        "x": nrm(ks[0], (BATCH, SEQ, D_MODEL), 1.0),
        "rel_bias": nrm(ks[1], (NUM_BUCKETS, N_BIAS_HEADS), 0.5),
        "norm_mix": 1.0 + nrm(ks[2], (DEPTH, D_MODEL), 0.02),
        "norm_ffn": 1.0 + nrm(ks[3], (DEPTH, D_MODEL), 0.02),
        "w_in": nrm(ks[4], (DEPTH, D_MODEL, PROJ_WIDTH), D_MODEL ** -0.5),
        "b_in": nrm(ks[5], (DEPTH, PROJ_WIDTH), 0.02),
        "cmp_pos_k": nrm(ks[6], (DEPTH, CMP_LEN, HEAD_DIM), 0.1),
        "cmp_pos_v": nrm(ks[7], (DEPTH, CMP_LEN, HEAD_DIM), 0.1),
        "cmp_k_w1": nrm(ks[8], (DEPTH, CMP_LEN * HEAD_DIM, CMP_HIDDEN), (CMP_LEN * HEAD_DIM) ** -0.5),
        "cmp_k_w2": nrm(ks[9], (DEPTH, CMP_HIDDEN, HEAD_DIM), CMP_HIDDEN ** -0.5),
        "cmp_v_w1": nrm(ks[10], (DEPTH, CMP_LEN * HEAD_DIM, CMP_HIDDEN), (CMP_LEN * HEAD_DIM) ** -0.5),
        "cmp_v_w2": nrm(ks[11], (DEPTH, CMP_HIDDEN, HEAD_DIM), CMP_HIDDEN ** -0.5),
        "sinks": nrm(ks[12], (DEPTH, SWA_HEADS), 1.0),
        "w_out": nrm(ks[13], (DEPTH, MIX_WIDTH, D_MODEL), MIX_WIDTH ** -0.5),
        "w_gate": nrm(ks[14], (DEPTH, D_MODEL, D_FF), D_MODEL ** -0.5),
        "w_up": nrm(ks[15], (DEPTH, D_MODEL, D_FF), D_MODEL ** -0.5),
        "w_down": nrm(ks[16], (DEPTH, D_FF, D_MODEL), D_FF ** -0.5),
        "norm_final": 1.0 + nrm(ks[17], (D_MODEL,), 0.02),
    }


def reference(x, rel_bias, norm_mix, norm_ffn, w_in, b_in, cmp_pos_k, cmp_pos_v,
              cmp_k_w1, cmp_k_w2, cmp_v_w1, cmp_v_w2, sinks, w_out, w_gate, w_up,
              w_down, norm_final):
    tbl_a = rel_bias[:, :NSA_HEADS]
    tbl_b = rel_bias[:, NSA_HEADS:]
    for layer in range(DEPTH):
        h = rms_norm(x, norm_mix[layer])
        proj = h @ w_in[layer] + b_in[layer]
        q_a, k_c, v_c, k_s, v_s, k_w, v_w, g_a, q_b, k_b, v_b = split_columns(proj)
        gates = jax.nn.sigmoid(g_a).reshape(g_a.shape[0], g_a.shape[1], NSA_HEADS, 3)
        o_a = nsa_attention(
            to_heads(q_a, NSA_HEADS),
            to_heads(k_c, NSA_KV_HEADS), to_heads(v_c, NSA_KV_HEADS),
            to_heads(k_s, NSA_KV_HEADS), to_heads(v_s, NSA_KV_HEADS),
            to_heads(k_w, NSA_KV_HEADS), to_heads(v_w, NSA_KV_HEADS),
            gates, tbl_a,
            cmp_pos_k[layer], cmp_pos_v[layer],
            cmp_k_w1[layer], cmp_k_w2[layer], cmp_v_w1[layer], cmp_v_w2[layer])
        o_b = swa_sink_attention(
            to_heads(q_b, SWA_HEADS), to_heads(k_b, SWA_KV_HEADS),
            to_heads(v_b, SWA_KV_HEADS), sinks[layer], tbl_b)
        x = x + jnp.concatenate([o_a, o_b], axis=-1) @ w_out[layer]
        h = rms_norm(x, norm_ffn[layer])
        x = x + (jax.nn.silu(h @ w_gate[layer]) * (h @ w_up[layer])) @ w_down[layer]
    return rms_norm(x, norm_final)
```

```cpp
#include <hip/hip_runtime.h>
#include <hip/hip_cooperative_groups.h>
#include <cstdio>
#include <cstdint>
namespace cg = cooperative_groups;
constexpr int SEQ = 4096, MTOK = 8192, DM = 2048, NPROJ = 3888, NP = 4096, DFF = 5632, NGU = 11264, DEPTH = 4;
constexpr int C_QA = 0, C_KC = 1024, C_VC = 1280, C_KS = 1536, C_VS = 1792, C_KW = 2048, C_VW = 2304, C_QB = 2560, C_KB = 3584, C_VB = 3712, C_GATE = 3840;
constexpr float LOG2E = 1.4426950408889634f;
constexpr float SCL2 = 0.125f * 1.4426950408889634f;
constexpr int LDS_BYTES = 147456, MISC_OFF = 131072 + 512;
constexpr int KSTR = 144;
constexpr int TILE_B = 64 * KSTR;

constexpr size_t MiB = 1u << 20;
constexpr size_t WS_BAR = 65536, WS_CTL_BYTES = 1 * MiB, WS_WIN = 1 * MiB, WS_WOUT = 17 * MiB, WS_WGU = 25 * MiB, WS_WDN = 69 * MiB, WS_C1K = 91 * MiB, WS_C1V = 92 * MiB,
                 WS_C2K = 93 * MiB, WS_C2V = 93 * MiB + 65536, WS_BIASP = 93 * MiB + 131072, WS_CBP = 93 * MiB + 196608, WS_BT = 93 * MiB + 262144,
                 WS_KC = 94 * MiB, WS_VC = 94 * MiB + 262144, WS_PROJ = 95 * MiB, WS_X = 159 * MiB, WS_XN = 223 * MiB, WS_AO = 255 * MiB,
                 WS_OW = 287 * MiB, WS_ACT = 303 * MiB, WS_OCB = 391 * MiB, WS_SSQ = 423 * MiB, WS_WDN_B = 424 * MiB, WS_WGU_B = 446 * MiB, WS_END = 490 * MiB;

struct Params { const float* in[18]; float* out; unsigned char* ws; };
typedef const __attribute__((address_space(4))) Params* PP;
#define KERNARGS(Pp) PP Pp = (PP)__builtin_amdgcn_kernarg_segment_ptr(); asm volatile("" : "+s"(Pp))
namespace pg8 {
#define PG8_LAS __attribute__((address_space(3)))
typedef unsigned short bf16_t;
typedef short bf16x8 __attribute__((ext_vector_type(8)));
typedef float f32x4 __attribute__((ext_vector_type(4)));
typedef unsigned u32x4 __attribute__((ext_vector_type(4)));
constexpr int BM = 256, BK = 64, HALF = 128, HTB = HALF * BK * 2  , STAGE_BYTES = 8 * HTB, NXCD = 8, WGM = 8;

__host__ __device__ __forceinline__ int lds_byte(int r, int c) { const int st = (r >> 4) * 2 + (c >> 5), rr = r & 15, cc = c & 31, ob = rr * 64 + cc * 2; return st * 1024 + (ob ^ (((ob >> 9) & 1) << 5)); }
__host__ __device__ __forceinline__ void stage_rc(int b, int& R, int& C) { const int st = b / 1024, sb = b % 1024, swz = sb ^ (((sb >> 9) & 1) << 5); R = (st >> 1) * 16 + swz / 64; C = (st & 1) * 32 + (swz % 64) / 2; }
__host__ __device__ __forceinline__ int perm32(int rho) { const int n = rho >> 4, i = rho & 15; return 8 * (i >> 2) + 4 * n + (i & 3); }

struct Unit { int pm, pn; };
struct Gemm { const bf16_t* A; const bf16_t* Bt; int M, N, K; };

struct StaticOrder {
    int nM, nN, nwg, G, c;
    __host__ __device__ void init(int M, int N, int G_, int c_) { nM = M / BM; nN = N / BM; nwg = nM * nN; G = G_; c = c_; }
    __host__ __device__ bool next(int i, Unit& u) const {
        const long L = (long)i * G + c; if (L >= nwg) return false;
        int wgid = (int)L; { const int q = nwg / NXCD, r = nwg % NXCD, xcd = wgid % NXCD, off = wgid / NXCD; wgid = (xcd < r ? xcd * (q + 1) : r * (q + 1) + (xcd - r) * q) + off; }
        const int nig = WGM * nN, gid = wgid / nig, fm = gid * WGM, gsz = (nM - fm) < WGM ? (nM - fm) : WGM;
        u.pm = fm + ((wgid % nig) % gsz); u.pn = (wgid % nig) / gsz; return true;
    }
    __device__ __forceinline__ void a_ready(const Unit&) const {}
    __device__ __forceinline__ void done(const Unit&) const {}
};

typedef float f32x2 __attribute__((ext_vector_type(2)));
typedef __bf16 bf16x2_t __attribute__((ext_vector_type(2)));
__device__ __forceinline__ unsigned cvt_pk_bf16(float lo, float hi) { const f32x2 v = {lo, hi}; const bf16x2_t b = __builtin_convertvector(v, bf16x2_t); return __builtin_bit_cast(unsigned, b); }
__device__ __forceinline__ f32x2 gelu_pk(f32x2 v) {
    const f32x2 av = __builtin_elementwise_abs(v), d = av * 0.2316418882f + 1.0f;
    f32x2 t; t.x = __builtin_amdgcn_rcpf(d.x); t.y = __builtin_amdgcn_rcpf(d.y);
    f32x2 q = t * 0.5307027145f + (-0.7265760135f); q = q * t + 0.7107068705f; q = q * t + (-0.142248368f); q = q * t + 0.127414796f; q = q * t;
    const f32x2 s = (v * v) * (-0.72134752044f);
    f32x2 e; e.x = __builtin_amdgcn_exp2f(s.x); e.y = __builtin_amdgcn_exp2f(s.y);
    const f32x2 m = v * (q * e), r = v - m;
    f32x2 o; o.x = v.x < 0.f ? m.x : r.x; o.y = v.y < 0.f ? m.y : r.y; return o;
}

template <int ACT  > struct EpiBf16 {
    static constexpr bool PERM = true, AFTER_DRAIN = false; static_assert(ACT == 0 || ACT == 1, "EpiBf16: ACT is 0 (none) or 1 (gelu_pk)");
    bf16_t* O; int ldc; const float* bias; int split_cols; size_t split_stride; float scale0;
    __device__ __forceinline__ void operator()(const f32x4 (&acc)[2][2][4][2], const Unit& u, int wr, int wc, int fr, int fq) const {
        const int row0 = u.pm * BM + wr * 64 + fr; int colt = u.pn * BM; bf16_t* base = O;
        float sc = 1.f; if (split_cols) { const int t = colt / split_cols; base += (size_t)t * split_stride; colt -= t * split_cols; if (t == 0) sc = scale0; }
        const int col0 = colt + wc * 32 + 8 * fq, bcol0 = u.pn * BM + wc * 32 + 8 * fq;
        f32x4 bv[2][2];
#pragma unroll
        for (int bj = 0; bj < 2; ++bj)
#pragma unroll
            for (int n = 0; n < 2; ++n) bv[bj][n] = bias ? *(const f32x4*)(bias + bcol0 + bj * HALF + 4 * n) : (f32x4){0.f, 0.f, 0.f, 0.f};
#pragma unroll
        for (int ai = 0; ai < 2; ++ai)
#pragma unroll
            for (int m = 0; m < 4; ++m) { bf16_t* rowp = base + (size_t)(row0 + ai * HALF + m * 16) * ldc + col0;
#pragma unroll
                for (int bj = 0; bj < 2; ++bj) { f32x4 v0 = acc[ai][bj][m][0] + bv[bj][0], v1 = acc[ai][bj][m][1] + bv[bj][1];
                    if (ACT == 1) { f32x2 a = gelu_pk((f32x2){v0[0], v0[1]}), b = gelu_pk((f32x2){v0[2], v0[3]}), c = gelu_pk((f32x2){v1[0], v1[1]}), d = gelu_pk((f32x2){v1[2], v1[3]});
                        v0 = (f32x4){a.x, a.y, b.x, b.y}; v1 = (f32x4){c.x, c.y, d.x, d.y}; }
                    v0 = v0 * sc; v1 = v1 * sc; u32x4 w; w.x = cvt_pk_bf16(v0[0], v0[1]); w.y = cvt_pk_bf16(v0[2], v0[3]); w.z = cvt_pk_bf16(v1[0], v1[1]); w.w = cvt_pk_bf16(v1[2], v1[3]);
                    *(u32x4*)(rowp + bj * HALF) = w; } }
    }
};

typedef unsigned u32x2 __attribute__((ext_vector_type(2)));
struct EpiResid {
    static constexpr bool PERM = true, AFTER_DRAIN = false;
    int l0, gi, gl, nocopy = 0;
    __device__ __forceinline__ void operator()(const f32x4 (&acc)[2][2][4][2], const Unit& u, int wr, int wc, int fr, int fq) const {
        KERNARGS(Pp); unsigned char* const ws = Pp->ws; const float* base = l0 ? Pp->in[0] : (const float*)(ws + WS_X); float* out = (float*)(ws + WS_X); bf16_t* xb = (bf16_t*)(ws + WS_XN); float* ssq = (float*)(ws + WS_SSQ); constexpr int ldc = DM;
        const int row0 = u.pm * BM + wr * 64 + fr, col0 = u.pn * BM + wc * 32 + 8 * fq;
        const float* gn = Pp->in[gi] + (size_t)gl * DM + col0; f32x4 gv[2][2];
#pragma unroll
        for (int bj = 0; bj < 2; ++bj) { gv[bj][0] = *(const f32x4*)(gn + bj * HALF); gv[bj][1] = *(const f32x4*)(gn + bj * HALF + 4); }
#pragma unroll
        for (int ai = 0; ai < 2; ++ai)
#pragma unroll
            for (int m = 0; m < 4; ++m) { const int row = row0 + ai * HALF + m * 16; const size_t off = (size_t)row * ldc + col0; float sq = 0.f;
#pragma unroll
                for (int bj = 0; bj < 2; ++bj) { const float* bp = base + off + bj * HALF; float* op = out + off + bj * HALF;
                    const f32x4 v0 = *(const f32x4*)bp + acc[ai][bj][m][0], v1 = *(const f32x4*)(bp + 4) + acc[ai][bj][m][1];
                    *(f32x4*)op = v0; *(f32x4*)(op + 4) = v1;
                    if (nocopy) continue;
                    const f32x4 h0 = v0 * gv[bj][0], h1 = v1 * gv[bj][1];
                    u32x4 w; w.x = cvt_pk_bf16(h0[0], h0[1]); w.y = cvt_pk_bf16(h0[2], h0[3]); w.z = cvt_pk_bf16(h1[0], h1[1]); w.w = cvt_pk_bf16(h1[2], h1[3]);
                    *(u32x4*)(xb + off + bj * HALF) = w;
                    sq += (v0[0] * v0[0] + v0[1] * v0[1]) + (v0[2] * v0[2] + v0[3] * v0[3]) + (v1[0] * v1[0] + v1[1] * v1[1]) + (v1[2] * v1[2] + v1[3] * v1[3]); }
                if (nocopy) continue;
                sq += __shfl_xor(sq, 16); sq += __shfl_xor(sq, 32);
                if (fq == 0) ssq[(size_t)row * 32 + u.pn * 4 + wc] = sq; }
    }
};
__device__ __forceinline__ void row_rinv(const float* ssq, int row0, int fq, float (&rinv)[2][4]) {
#pragma unroll
    for (int ai = 0; ai < 2; ++ai)
#pragma unroll
        for (int m = 0; m < 4; ++m) { const f32x4* p = (const f32x4*)(ssq + (size_t)(row0 + ai * HALF + m * 16) * 32) + 2 * fq; const f32x4 a = p[0] + p[1];
            float s = (a[0] + a[1]) + (a[2] + a[3]); s += __shfl_xor(s, 16); s += __shfl_xor(s, 32);
            rinv[ai][m] = 1.0f / sqrtf(s * (1.0f / 2048.0f) + 1e-5f); }
}
struct EpiProjN {
    static constexpr bool PERM = true, AFTER_DRAIN = false;
    int dummy;
    __device__ __forceinline__ void operator()(const f32x4 (&acc)[2][2][4][2], const Unit& u, int wr, int wc, int fr, int fq) const {
        KERNARGS(Pp); unsigned char* const ws = Pp->ws; bf16_t* O = (bf16_t*)(ws + WS_PROJ); constexpr int ldc = NP; const float* bias = (const float*)(ws + WS_BIASP); const float* ssq = (const float*)(ws + WS_SSQ);
        const int row0 = u.pm * BM + wr * 64 + fr, col0 = u.pn * BM + wc * 32 + 8 * fq;
        float rinv[2][4]; row_rinv(ssq, row0, fq, rinv);
        f32x4 bv[2][2];
#pragma unroll
        for (int bj = 0; bj < 2; ++bj)
#pragma unroll
            for (int n = 0; n < 2; ++n) bv[bj][n] = *(const f32x4*)(bias + col0 + bj * HALF + 4 * n);
#pragma unroll
        for (int ai = 0; ai < 2; ++ai)
#pragma unroll
            for (int m = 0; m < 4; ++m) { bf16_t* rowp = O + (size_t)(row0 + ai * HALF + m * 16) * ldc + col0; const float r = rinv[ai][m];
#pragma unroll
                for (int bj = 0; bj < 2; ++bj) { const f32x4 v0 = acc[ai][bj][m][0] * r + bv[bj][0], v1 = acc[ai][bj][m][1] * r + bv[bj][1];
                    u32x4 w; w.x = cvt_pk_bf16(v0[0], v0[1]); w.y = cvt_pk_bf16(v0[2], v0[3]); w.z = cvt_pk_bf16(v1[0], v1[1]); w.w = cvt_pk_bf16(v1[2], v1[3]);
                    *(u32x4*)(rowp + bj * HALF) = w; } }
    }
};
__device__ __forceinline__ float silu_f(float x) { return x * __builtin_amdgcn_rcpf(1.0f + __expf(-x)); }
struct EpiSwiGLU {
    static constexpr bool PERM = true, AFTER_DRAIN = false;
    int dummy;
    __device__ __forceinline__ void operator()(const f32x4 (&acc)[2][2][4][2], const Unit& u, int wr, int wc, int fr, int fq) const {
        KERNARGS(Pp); unsigned char* const ws = Pp->ws; bf16_t* O = (bf16_t*)(ws + WS_ACT); constexpr int ldc = DFF; const float* ssq = (const float*)(ws + WS_SSQ);
        const int row0 = u.pm * BM + wr * 64 + fr, colh = u.pn * (BM / 2) + wc * 32 + 8 * fq;
        float rinv[2][4]; row_rinv(ssq, row0, fq, rinv);
#pragma unroll
        for (int ai = 0; ai < 2; ++ai)
#pragma unroll
            for (int m = 0; m < 4; ++m) { bf16_t* rowp = O + (size_t)(row0 + ai * HALF + m * 16) * ldc + colh; const float r = rinv[ai][m];
                const f32x4 g0 = acc[ai][0][m][0] * r, g1 = acc[ai][0][m][1] * r, u0 = acc[ai][1][m][0] * r, u1 = acc[ai][1][m][1] * r;
                u32x4 w; w.x = cvt_pk_bf16(silu_f(g0[0]) * u0[0], silu_f(g0[1]) * u0[1]); w.y = cvt_pk_bf16(silu_f(g0[2]) * u0[2], silu_f(g0[3]) * u0[3]);
                w.z = cvt_pk_bf16(silu_f(g1[0]) * u1[0], silu_f(g1[1]) * u1[1]); w.w = cvt_pk_bf16(silu_f(g1[2]) * u1[2], silu_f(g1[3]) * u1[3]);
                *(u32x4*)rowp = w; }
    }
};
template <class Epi, class Sched, bool ALIGN_EPI = false, bool SP2 = false>
__device__ __forceinline__ void gemm_phase(PG8_LAS unsigned char* lds, const Gemm g, const Sched& S, const Epi& E) {
    int tid_o = threadIdx.x; asm volatile("" : "+v"(tid_o));
    const int tid = tid_o, wid = __builtin_amdgcn_readfirstlane(tid >> 6), lane = tid & 63, wr = wid >> 2, wc = wid & 3, fr = lane & 15, fq = lane >> 4;
    const int K = g.K, nt = K / BK;
    unsigned voffA[2], voffB[2];
#pragma unroll
    for (int i = 0; i < 2; ++i) { int R, C; stage_rc(tid * 16 + i * 8192, R, C); const int Rb = Epi::PERM ? ((R & ~31) + perm32(R & 31)) : R;
        voffA[i] = (unsigned)(R * K + C) * 2u; voffB[i] = (unsigned)(Rb * K + C) * 2u; }
    const size_t kstep = (size_t)(BK * 2);
    const size_t hstep = (size_t)HALF * K * 2;
    const size_t tstep = 2 * hstep;
    const unsigned ldsw = (unsigned)wid * 1024u;
    const int aoff = lds_byte(wr * 64 + fr, fq * 8), boff = lds_byte(wc * 32 + fr, fq * 8);
#define PG8_SA(b, h) (((b) * 2 + (h)) * HTB)
#define PG8_SB(b, h) ((4 + (b) * 2 + (h)) * HTB)
#define PG8_STAGE(bufoff, gbase, voff) do { _Pragma("unroll") for (int _i = 0; _i < 2; ++_i) \
        __builtin_amdgcn_global_load_lds((const unsigned*)((const char*)(gbase) + (voff)[_i]), (PG8_LAS unsigned*)(lds + (bufoff) + ldsw + _i * 8192), 16, 0, 0); } while (0)
#define PG8_LDA(dst, b, h) do { _Pragma("unroll") for (int m = 0; m < 4; ++m) _Pragma("unroll") for (int k = 0; k < 2; ++k) dst[m][k] = *(const PG8_LAS bf16x8*)(lds + PG8_SA(b, h) + aoff + m * 2048 + k * 1024); } while (0)
#define PG8_LDB(dst, b, h) do { _Pragma("unroll") for (int n = 0; n < 2; ++n) _Pragma("unroll") for (int k = 0; k < 2; ++k) dst[n][k] = *(const PG8_LAS bf16x8*)(lds + PG8_SB(b, h) + boff + n * 2048 + k * 1024); } while (0)
#define PG8_MMA(ai, bj, At, Bt) do { __builtin_amdgcn_s_setprio(1); _Pragma("unroll") for (int m = 0; m < 4; ++m) _Pragma("unroll") for (int n = 0; n < 2; ++n) _Pragma("unroll") for (int k = 0; k < 2; ++k) \
        acc[ai][bj][m][n] = __builtin_amdgcn_mfma_f32_16x16x32_bf16(Bt[n][k], At[m][k], acc[ai][bj][m][n], 0, 0, 0); __builtin_amdgcn_s_setprio(0); } while (0)
#define PG8_WAIT_V(n) asm volatile("s_waitcnt vmcnt(" #n ")" ::: "memory")
#define PG8_WAIT_L(n) asm volatile("s_waitcnt lgkmcnt(" #n ")" ::: "memory")
#define PG8_BAR __builtin_amdgcn_s_barrier()
#define PG8_SCHED __builtin_amdgcn_sched_barrier(0)
    Unit cur, nxt; int ui = 0;
    if (!S.next(0, cur)) return;
    f32x4 acc[2][2][4][2];
#pragma unroll
    for (int a = 0; a < 2; ++a)
#pragma unroll
        for (int b = 0; b < 2; ++b)
#pragma unroll
            for (int m = 0; m < 4; ++m)
#pragma unroll
                for (int n = 0; n < 2; ++n) acc[a][b][m][n] = (f32x4){0.f, 0.f, 0.f, 0.f};
    bf16x8 At[4][2], B0[2][2], B1[2][2];
    const char* cA = (const char*)g.A + (size_t)cur.pm * tstep; const char* cB = (const char*)g.Bt + (size_t)cur.pn * tstep;
    S.a_ready(cur);
    if constexpr (SP2) {
        PG8_STAGE(PG8_SB(0, 0), cB, voffB); PG8_STAGE(PG8_SB(0, 1), cB + hstep, voffB); PG8_STAGE(PG8_SA(0, 0), cA, voffA); PG8_STAGE(PG8_SA(0, 1), cA + hstep, voffA);
        if (wr == 1) PG8_BAR;
        PG8_WAIT_V(2); PG8_BAR;
        PG8_STAGE(PG8_SB(1, 0), cB + kstep, voffB); PG8_STAGE(PG8_SA(1, 0), cA + kstep, voffA); PG8_STAGE(PG8_SB(1, 1), cB + hstep + kstep, voffB);
        PG8_WAIT_V(6); PG8_BAR;
    } else {
        PG8_STAGE(PG8_SB(0, 0), cB, voffB); PG8_STAGE(PG8_SA(0, 0), cA, voffA); PG8_STAGE(PG8_SB(0, 1), cB + hstep, voffB); PG8_STAGE(PG8_SA(0, 1), cA + hstep, voffA);
        if (wr == 1) PG8_BAR;
        PG8_WAIT_V(4); PG8_BAR;
        PG8_STAGE(PG8_SB(1, 0), cB + kstep, voffB); PG8_STAGE(PG8_SA(1, 0), cA + kstep, voffA); PG8_STAGE(PG8_SB(1, 1), cB + hstep + kstep, voffB);
        PG8_WAIT_V(6); PG8_BAR;
    }
    for (;;) {
        const bool has_next = S.next(ui + 1, nxt);
        const char* nA = has_next ? (const char*)g.A + (size_t)nxt.pm * tstep : cA; const char* nB = has_next ? (const char*)g.Bt + (size_t)nxt.pn * tstep : cB;
        for (int t = 0; t < nt; t += 2) {
            const bool last = (t == nt - 2);
            const char* a1 = cA + (size_t)(t + 1) * kstep;
            const char* a2 = last ? nA : cA + (size_t)(t + 2) * kstep; const char* b2 = last ? nB : cB + (size_t)(t + 2) * kstep;
            const char* a3 = a2 + kstep; const char* b3 = b2 + kstep;
            if (last && has_next) S.a_ready(nxt);
            if constexpr (SP2) {
            PG8_LDB(B0, 0, 0); PG8_LDB(B1, 0, 1); PG8_SCHED; PG8_LDA(At, 0, 0); PG8_STAGE(PG8_SA(1, 1), a1 + hstep, voffA);
            PG8_WAIT_V(8); PG8_WAIT_L(0); PG8_BAR; PG8_MMA(0, 0, At, B0); PG8_MMA(0, 1, At, B1); PG8_BAR; PG8_SCHED;
            PG8_LDA(At, 0, 1); PG8_STAGE(PG8_SB(0, 0), b2, voffB); PG8_STAGE(PG8_SB(0, 1), b2 + hstep, voffB); PG8_STAGE(PG8_SA(0, 0), a2, voffA);
            PG8_WAIT_V(8); PG8_WAIT_L(0); PG8_BAR; PG8_MMA(1, 0, At, B0); PG8_MMA(1, 1, At, B1); PG8_BAR; PG8_SCHED;
            PG8_LDB(B0, 1, 0); PG8_LDB(B1, 1, 1); PG8_SCHED; PG8_LDA(At, 1, 0); PG8_STAGE(PG8_SA(0, 1), a2 + hstep, voffA);
            PG8_WAIT_V(8); PG8_WAIT_L(0); PG8_BAR; PG8_MMA(0, 0, At, B0); PG8_MMA(0, 1, At, B1); PG8_BAR; PG8_SCHED;
            PG8_LDA(At, 1, 1); PG8_STAGE(PG8_SB(1, 0), b3, voffB); PG8_STAGE(PG8_SB(1, 1), b3 + hstep, voffB); PG8_STAGE(PG8_SA(1, 0), a3, voffA);
            PG8_WAIT_V(8); PG8_WAIT_L(0); PG8_BAR; PG8_MMA(1, 0, At, B0); PG8_MMA(1, 1, At, B1); PG8_BAR; PG8_SCHED;
            } else {
            PG8_LDB(B0, 0, 0); PG8_SCHED; PG8_LDA(At, 0, 0); PG8_STAGE(PG8_SA(1, 1), a1 + hstep, voffA);
            PG8_WAIT_L(8); PG8_BAR; PG8_WAIT_L(0); PG8_MMA(0, 0, At, B0); PG8_BAR; PG8_SCHED;
            PG8_LDB(B1, 0, 1); PG8_STAGE(PG8_SB(0, 0), b2, voffB);
            PG8_BAR; PG8_WAIT_L(0); PG8_MMA(0, 1, At, B1); PG8_BAR;
            PG8_LDA(At, 0, 1); PG8_STAGE(PG8_SA(0, 0), a2, voffA);
            PG8_BAR; PG8_WAIT_L(0); PG8_MMA(1, 0, At, B0); PG8_BAR; PG8_SCHED;
            PG8_STAGE(PG8_SB(0, 1), b2 + hstep, voffB);
            PG8_WAIT_V(6); PG8_BAR; PG8_MMA(1, 1, At, B1); PG8_BAR;
            PG8_LDB(B0, 1, 0); PG8_SCHED; PG8_LDA(At, 1, 0); PG8_STAGE(PG8_SA(0, 1), a2 + hstep, voffA);
            PG8_WAIT_L(8); PG8_BAR; PG8_WAIT_L(0); PG8_MMA(0, 0, At, B0); PG8_BAR; PG8_SCHED;
            PG8_LDB(B1, 1, 1); PG8_STAGE(PG8_SB(1, 0), b3, voffB);
            PG8_BAR; PG8_WAIT_L(0); PG8_MMA(0, 1, At, B1); PG8_BAR;
            PG8_LDA(At, 1, 1); PG8_STAGE(PG8_SA(1, 0), a3, voffA);
            PG8_BAR; PG8_WAIT_L(0); PG8_MMA(1, 0, At, B0); PG8_BAR; PG8_SCHED;
            PG8_STAGE(PG8_SB(1, 1), b3 + hstep, voffB);
            PG8_WAIT_V(6); PG8_BAR; PG8_MMA(1, 1, At, B1); PG8_BAR;
            }
        }
        if constexpr (ALIGN_EPI) { if (wr == 0) PG8_BAR; }
        if constexpr (!Epi::AFTER_DRAIN) { E(acc, cur, wr, wc, fr, fq); S.done(cur); }
        if (!has_next) break;
#pragma unroll
        for (int a = 0; a < 2; ++a)
#pragma unroll
            for (int b = 0; b < 2; ++b)
#pragma unroll
                for (int m = 0; m < 4; ++m)
#pragma unroll
                    for (int n = 0; n < 2; ++n) acc[a][b][m][n] = (f32x4){0.f, 0.f, 0.f, 0.f};
        cur = nxt; cA = nA; cB = nB; ++ui;
        if constexpr (ALIGN_EPI) { if (wr == 1) PG8_BAR; }
    }
    PG8_WAIT_V(0);
    if constexpr (!ALIGN_EPI) { if (wr == 0) PG8_BAR; }
    PG8_BAR;
    if constexpr (Epi::AFTER_DRAIN) { E.fused(acc, cur, wr, wc, fr, fq, lds, wid, lane); S.done(cur); }
#undef PG8_SA
#undef PG8_SB
#undef PG8_STAGE
#undef PG8_LDA
#undef PG8_LDB
#undef PG8_MMA
#undef PG8_WAIT_V
#undef PG8_WAIT_L
#undef PG8_BAR
#undef PG8_SCHED
}
}

#define LAS __attribute__((address_space(3)))
using pg8::bf16_t; using pg8::bf16x8; using pg8::f32x4; using pg8::u32x4; using pg8::u32x2; using pg8::cvt_pk_bf16;
typedef short s16x4 __attribute__((ext_vector_type(4)));

#define LDS_WAIT() asm volatile("s_waitcnt lgkmcnt(0)" ::: "memory")
__device__ __forceinline__ float bf2f(unsigned short b) { return __uint_as_float(((unsigned)b) << 16); }
__device__ __forceinline__ unsigned short f2bf1(float f) { return (unsigned short)(cvt_pk_bf16(f, 0.f) & 0xffffu); }
__device__ __forceinline__ float wave_sum(float v) {
#pragma unroll
    for (int o = 1; o < 64; o <<= 1) v += __shfl_xor(v, o);
    return v;
}
__device__ __forceinline__ f32x4 mfma16(bf16x8 a, bf16x8 b, f32x4 c) { return __builtin_amdgcn_mfma_f32_16x16x32_bf16(a, b, c, 0, 0, 0); }
__device__ __forceinline__ s16x4 tr16(const LAS unsigned char* p) { return __builtin_amdgcn_ds_read_tr16_b64_v4i16((LAS s16x4*)p); }

__device__ __forceinline__ int t5_bucket(int d) {
    if (d < 16) return d;
    return 16 + (d >= 21) + (d >= 27) + (d >= 35) + (d >= 46) + (d >= 59) + (d >= 77) + (d >= 99) + (d >= 128) + (d >= 166) + (d >= 216) + (d >= 280) + (d >= 363) + (d >= 470) + (d >= 609) + (d >= 790);
}
__device__ __forceinline__ int proj_map(int n) { return n < 2560 ? n : (n < 2608 ? n + 1280 : (n < NPROJ ? n - 48 : n)); }

__device__ __forceinline__ void tr_item(const float* __restrict__ W, int K, int Nsrc, int nblk, bf16_t* WT, int mode, int roff, LAS unsigned char* scr, int item, int lane) {
    const int kg = item / nblk, nb = item - kg * nblk, k0 = 64 * kg, n0 = 128 * nb;
    const int nq = lane & 31, kh = lane >> 5, n = n0 + 4 * nq; const bool ok = n < Nsrc;
    const float* wp = W + (size_t)(k0 + 32 * kh) * Nsrc + n;
#pragma unroll 2
    for (int b = 0; b < 4; ++b) {
        f32x4 v[8];
#pragma unroll
        for (int j = 0; j < 8; ++j) v[j] = ok ? *(const f32x4*)(wp + (size_t)(8 * b + j) * Nsrc) : (f32x4){0.f, 0.f, 0.f, 0.f};
#pragma unroll
        for (int c = 0; c < 4; ++c) { u32x4 o; o.x = cvt_pk_bf16(v[0][c], v[1][c]); o.y = cvt_pk_bf16(v[2][c], v[3][c]); o.z = cvt_pk_bf16(v[4][c], v[5][c]); o.w = cvt_pk_bf16(v[6][c], v[7][c]);
            *(LAS u32x4*)(scr + (4 * nq + c) * 128 + (((4 * kh + b) ^ (nq & 7)) << 4)) = o; }
    }
    LDS_WAIT(); asm volatile("" ::: "memory");
#pragma unroll 4
    for (int s = 0; s < 16; ++s) { const int row = 8 * s + (lane >> 3), ch = lane & 7, dn = n0 + row;
        if (dn < Nsrc || mode == 1) { const u32x4 o = *(const LAS u32x4*)(scr + row * 128 + ((ch ^ ((row >> 2) & 7)) << 4));
            const int dr = mode == 1 ? proj_map(dn) : (mode == 2 ? ((dn >> 7) << 8) + (roff << 7) + (dn & 127) : dn);
            *(u32x4*)(WT + (size_t)dr * K + k0 + 8 * ch) = o; } }
    LDS_WAIT(); asm volatile("" ::: "memory");
}

constexpr int PREP_NITEMS = 32 * 32 + 32 * 16 + 2 * (32 * 44) + 88 * 16 + 2 * (32 * 2) + 2 * (4 * 1) + 256;
constexpr int PREP_EARLY = 2432;
__device__ __forceinline__ void prep_phase(const __attribute__((address_space(4))) Params* Pq, int L, LAS unsigned char* lds, int gw, int ngw, int tid, int lane, int wave, int it_lo = 0, int it_hi = PREP_NITEMS, bool tail_part = true) {
    const __attribute__((address_space(4))) Params& P = *Pq;
    unsigned char* ws = P.ws;
    constexpr int I_IN = 32 * 32, I_OUT = 32 * 16, I_G = 32 * 44, I_DN = 88 * 16, I_C1 = 32 * 2, I_C2 = 4 * 1, I_CB = 256;
    LAS unsigned char* scr = lds + wave * 16384;
    constexpr int NITEMS = I_IN + I_OUT + 2 * I_G + I_DN + 2 * I_C1 + 2 * I_C2 + I_CB;
    static_assert(NITEMS == PREP_NITEMS && PREP_EARLY <= 2 * I_G, "prep item table");
    for (int it = it_lo + gw; it < it_hi; it += ngw) {
        int r = it; const float* W; bf16_t* WT; int K, Ns, nblk, mode = 0, roff = 0;
        if (r < 2 * I_G) { const int up = r >= I_G; r -= up * I_G; W = P.in[14 + up] + (size_t)L * DM * DFF; WT = (bf16_t*)(ws + ((L & 1) ? WS_WGU_B : WS_WGU)); K = DM; Ns = DFF; nblk = 44; mode = 2; roff = up; }
        else if ((r -= 2 * I_G) < I_DN) { W = P.in[16] + (size_t)L * DFF * DM; WT = (bf16_t*)(ws + ((L & 1) ? WS_WDN_B : WS_WDN)); K = DFF; Ns = DM; nblk = 16; }
        else if ((r -= I_DN) < I_IN) { W = P.in[4] + (size_t)L * DM * NPROJ; WT = (bf16_t*)(ws + WS_WIN); K = DM; Ns = NPROJ; nblk = 32; mode = 1; }
        else if ((r -= I_IN) < I_OUT) { W = P.in[13] + (size_t)L * DM * DM; WT = (bf16_t*)(ws + WS_WOUT); K = DM; Ns = DM; nblk = 16; }
        else if ((r -= I_OUT) < 2 * I_C1) { const int v = r >= I_C1; r -= v * I_C1; W = P.in[8 + 2 * v] + (size_t)L * 2048 * 256; WT = (bf16_t*)(ws + (v ? WS_C1V : WS_C1K)); K = 2048; Ns = 256; nblk = 2; }
        else if ((r -= 2 * I_C1) < 2 * I_C2) { const int v = r >= I_C2; r -= v * I_C2; W = P.in[9 + 2 * v] + (size_t)L * 256 * 64; WT = (bf16_t*)(ws + (v ? WS_C2V : WS_C2K)); K = 256; Ns = 64; nblk = 1; }
        else {
            r -= 2 * I_C2;
            const int mat = r >> 7, kch = (r >> 2) & 31, n = 64 * (r & 3) + lane;
            const float* pos = P.in[6 + mat] + (size_t)L * 2048 + 64 * kch; const float* w1 = P.in[8 + 2 * mat] + (size_t)L * 2048 * 256 + (size_t)(64 * kch) * 256 + n;
            float s = 0.f;
#pragma unroll 16
            for (int k = 0; k < 64; ++k) s += pos[k] * w1[(size_t)k * 256];
            ((float*)(ws + WS_CBP))[(mat * 32 + kch) * 256 + n] = s;
            continue;
        }
        tr_item(W, K, Ns, nblk, WT, mode, roff, scr, r, lane);
    }
    if (!tail_part) return;
    const int gt = gw * 64 + lane;
    if (gt < NP) { const int d = gt; float v = 0.f;
        if (d < NPROJ) { const int src = d < 2560 ? d : (d < 3840 ? d + 48 : d - 1280); v = P.in[5][(size_t)L * NPROJ + src]; }
        ((float*)(ws + WS_BIASP))[d] = v; }
    if (L == 0) {
        for (int e = gt; e < 32 * 1024; e += ngw * 64) { const int h = e >> 10, d = 1023 - (e & 1023); ((float*)(ws + WS_BT))[e] = P.in[1][t5_bucket(d) * 32 + h] * LOG2E; }
    }
}

__device__ __forceinline__ void rows_bf16_ssq(const float* x, const float* gwt, bf16_t* xb, float* ssq, int gw, int ngw, int lane) {
    for (int m = gw; m < MTOK; m += ngw) {
        const f32x4* xr = (const f32x4*)(x + (size_t)m * DM) + lane; u32x2* o = (u32x2*)(xb + (size_t)m * DM) + lane; float s = 0.f;
#pragma unroll
        for (int j = 0; j < 8; ++j) { const f32x4 v = xr[64 * j]; s += (v[0] * v[0] + v[1] * v[1]) + (v[2] * v[2] + v[3] * v[3]); const f32x4 h = v * ((const f32x4*)gwt + lane)[64 * j];
            u32x2 w; w.x = cvt_pk_bf16(h[0], h[1]); w.y = cvt_pk_bf16(h[2], h[3]); o[64 * j] = w; }
        s = wave_sum(s);
        if (lane < 32) ssq[(size_t)m * 32 + lane] = lane == 0 ? s : 0.f;
    }
}
__device__ __forceinline__ void norm_rows_f32(const float* __restrict__ x, const float* __restrict__ gwt, float* __restrict__ out, int gw, int ngw, int lane) {
    for (int m = gw; m < MTOK; m += 2 * ngw) {
        const int m1 = m + ngw; const bool two = m1 < MTOK;
        const f32x4* xr0 = (const f32x4*)(x + (size_t)m * DM) + lane; const f32x4* xr1 = (const f32x4*)(x + (size_t)(two ? m1 : m) * DM) + lane;
        f32x4 v0[8], v1[8]; float s0 = 0.f, s1 = 0.f;
#pragma unroll
        for (int j = 0; j < 8; ++j) { v0[j] = xr0[64 * j]; v1[j] = xr1[64 * j]; }
#pragma unroll
        for (int j = 0; j < 8; ++j) { s0 += (v0[j][0] * v0[j][0] + v0[j][1] * v0[j][1]) + (v0[j][2] * v0[j][2] + v0[j][3] * v0[j][3]); s1 += (v1[j][0] * v1[j][0] + v1[j][1] * v1[j][1]) + (v1[j][2] * v1[j][2] + v1[j][3] * v1[j][3]); }
        const float r0 = 1.0f / sqrtf(wave_sum(s0) * (1.0f / DM) + 1e-5f), r1 = 1.0f / sqrtf(wave_sum(s1) * (1.0f / DM) + 1e-5f);
        const f32x4* gr = (const f32x4*)gwt + lane; f32x4* o0 = (f32x4*)(out + (size_t)m * DM) + lane; f32x4* o1 = (f32x4*)(out + (size_t)m1 * DM) + lane;
#pragma unroll
        for (int j = 0; j < 8; ++j) { const f32x4 gg = gr[64 * j]; o0[64 * j] = v0[j] * r0 * gg; if (two) o1[64 * j] = v1[j] * r1 * gg; }
    }
}

constexpr int TILE_U = 8192;
constexpr int REP_SEL = 1;
__device__ __forceinline__ void stage_tile(LAS unsigned char* dst, const bf16_t* src, size_t rstride, int tid) {
    const int r = tid >> 3, ch = tid & 7;
    const u32x4 v = *(const u32x4*)(src + (size_t)r * rstride + ch * 8);
    *(LAS u32x4*)(dst + r * 128 + ((ch ^ (r & 7)) << 4)) = v;
}
__device__ __forceinline__ void dma_tile(LAS unsigned char* dstK, const bf16_t* ksrc, const bf16_t* vsrc, size_t rstride, int lane, int wave) {
    const int rl = lane >> 3, c = (lane & 7) ^ rl;
    const size_t off = (size_t)(8 * wave + rl) * rstride + c * 8;
    __builtin_amdgcn_global_load_lds((const unsigned*)(ksrc + off), (LAS unsigned*)(dstK + wave * 1024), 16, 0, 0);
    __builtin_amdgcn_global_load_lds((const unsigned*)(vsrc + off), (LAS unsigned*)(dstK + TILE_U + wave * 1024), 16, 0, 0);
}
#define RING_WAIT_BARRIER(rem) do { if ((rem) >= 2) asm volatile("s_waitcnt vmcnt(4)" ::: "memory"); else if ((rem) == 1) asm volatile("s_waitcnt vmcnt(2)" ::: "memory"); \
    else asm volatile("s_waitcnt vmcnt(0)" ::: "memory"); asm volatile("s_waitcnt lgkmcnt(0)" ::: "memory"); __builtin_amdgcn_s_barrier(); asm volatile("" ::: "memory"); } while (0)
constexpr int RING_PD = 3, RING_NB = 4;
#define RING_PAIR_BARRIER() do { asm volatile("s_waitcnt vmcnt(0)" ::: "memory"); asm volatile("s_waitcnt lgkmcnt(0)" ::: "memory"); __builtin_amdgcn_s_barrier(); asm volatile("" ::: "memory"); } while (0)

template <int MODE, int PATH, int TSH = 0>
__device__ __forceinline__ void flash_tile(const LAS unsigned char* Kt, const LAS unsigned char* Vt, const LAS float* biasT, const bf16x8 (&qf)[2][2],
                                           f32x4 (&o)[2][4], float (&m)[2], float (&l)[2], int tq0, int kp0, int W,
                                           unsigned long long mk0, unsigned long long mk1, int jblk, int dm1, int lane) {
    const int i16 = lane & 15, g = lane >> 4;
    const int ksw0 = (g ^ (i16 & 7)) << 4, ksw1 = ((4 + g) ^ (i16 & 7)) << 4;
    bool bits[2] = {true, true};
    if (MODE == 1) { bits[0] = ((mk0 >> jblk) & 1ull) != 0ull; bits[1] = ((mk1 >> jblk) & 1ull) != 0ull;
        if (__ballot(bits[0] || bits[1]) == 0ull) return; }
    bf16x8 pf[2][2];
#pragma unroll
    for (int cb = 0; cb < 2; ++cb) {
        const bool bit = bits[cb];
        if (MODE == 1 && __ballot(bit) == 0ull) { pf[cb][0] = (bf16x8){0, 0, 0, 0, 0, 0, 0, 0}; pf[cb][1] = (bf16x8){0, 0, 0, 0, 0, 0, 0, 0}; continue; }
        f32x4 s[4];
        {
            bf16x8 ka[4][2];
#pragma unroll
            for (int kb = 0; kb < 4; ++kb) { const LAS unsigned char* kr = Kt + (16 * kb + i16) * 128; ka[kb][0] = *(const LAS bf16x8*)(kr + ksw0); ka[kb][1] = *(const LAS bf16x8*)(kr + ksw1); }
#pragma unroll
            for (int kb = 0; kb < 4; ++kb) { f32x4 z = {0.f, 0.f, 0.f, 0.f}; z = mfma16(ka[kb][0], qf[cb][0], z); z = mfma16(ka[kb][1], qf[cb][1], z); s[kb] = z; }
        }
        const int tq = tq0 + ((16 * cb + i16) >> TSH);
        float tmax = -1e30f, sub;
        if (PATH == 0) {
#pragma unroll
            for (int kb = 0; kb < 4; ++kb)
#pragma unroll
                for (int r = 0; r < 4; ++r) {
                    const int kk = kp0 + 16 * kb + 4 * g + r;
                    int dist; bool valid;
                    if (MODE == 2) { dist = tq - (16 * kk + 31); valid = dist >= 0 && kk < 255; }
                    else if (MODE == 0) { dist = tq - kk; valid = dist >= 0 && dist < W; }
                    else { dist = tq - kk; valid = dist >= 0 && bit; }
                    const int di = min(max(dist, 0), dm1);
                    float t = s[kb][r] * SCL2 + biasT[dm1 - di];
                    t = valid ? t : -1e30f;
                    s[kb][r] = t; tmax = fmaxf(tmax, t);
                }
        } else {
            if (PATH == 1) { constexpr int KS = MODE == 2 ? 16 : 1;
                const LAS float* pb = biasT + (MODE == 2 ? dm1 - tq + 31 + 16 * kp0 + 64 * g : dm1 - tq + kp0 + 4 * g);
#pragma unroll
                for (int kb = 0; kb < 4; ++kb) { const f32x4 b4 = {pb[KS * 16 * kb], pb[KS * (16 * kb + 1)], pb[KS * (16 * kb + 2)], pb[KS * (16 * kb + 3)]}; s[kb] = s[kb] * SCL2 + b4; } }
            else { const float bc = biasT[dm1 - 1023];
#pragma unroll
                for (int kb = 0; kb < 4; ++kb) s[kb] = s[kb] * SCL2 + bc; }
#pragma unroll
            for (int kb = 0; kb < 4; ++kb) tmax = fmaxf(fmaxf(tmax, fmaxf(s[kb][0], s[kb][1])), fmaxf(s[kb][2], s[kb][3]));
        }
        tmax = fmaxf(tmax, __shfl_xor(tmax, 16)); tmax = fmaxf(tmax, __shfl_xor(tmax, 32));
        if (MODE == 1 && PATH != 0) tmax = bit ? tmax : -1e30f;
        const float mn = fmaxf(m[cb], tmax), alpha = __builtin_amdgcn_exp2f(m[cb] - mn);
        m[cb] = mn; float ls = l[cb] * alpha;
        sub = (MODE == 1 && PATH != 0 && !bit) ? 1e30f : mn;
#pragma unroll
        for (int c = 0; c < 4; ++c) o[cb][c] = o[cb][c] * alpha;
#pragma unroll
        for (int kb = 0; kb < 4; ++kb)
#pragma unroll
            for (int r = 0; r < 4; ++r) { const float t = s[kb][r];
                const float pv = PATH == 0 ? (t > -1e29f ? __builtin_amdgcn_exp2f(t - mn) : 0.f) : __builtin_amdgcn_exp2f(t - sub);
                s[kb][r] = pv; ls += pv; }
        l[cb] = ls;
#pragma unroll
        for (int ks = 0; ks < 2; ++ks) { u32x4 w; w.x = cvt_pk_bf16(s[2 * ks][0], s[2 * ks][1]); w.y = cvt_pk_bf16(s[2 * ks][2], s[2 * ks][3]);
            w.z = cvt_pk_bf16(s[2 * ks + 1][0], s[2 * ks + 1][1]); w.w = cvt_pk_bf16(s[2 * ks + 1][2], s[2 * ks + 1][3]); pf[cb][ks] = __builtin_bit_cast(bf16x8, w); }
        asm volatile("" ::: "memory");
    }
    const int vr = 4 * g + (i16 >> 2), p4 = lane & 3;
    const LAS unsigned char* vb = Vt + vr * 128 + 8 * (p4 & 1);
#pragma unroll
    for (int ks = 0; ks < 2; ++ks) {
        bf16x8 vf[4];
#pragma unroll
        for (int c = 0; c < 4; ++c) {
            const int vsw = ((2 * c + (p4 >> 1)) ^ (vr & 7)) << 4;
            const s16x4 v0 = tr16(vb + (32 * ks) * 128 + vsw), v1 = tr16(vb + (32 * ks + 16) * 128 + vsw);
            vf[c] = (bf16x8){v0[0], v0[1], v0[2], v0[3], v1[0], v1[1], v1[2], v1[3]};
        }
#pragma unroll
        for (int c = 0; c < 4; ++c)
#pragma unroll
            for (int cb = 0; cb < 2; ++cb) o[cb][c] = mfma16(vf[c], pf[cb][ks], o[cb][c]);
    }
}

#define FLASH_INIT(o, m, l) do { _Pragma("unroll") for (int cb_ = 0; cb_ < 2; ++cb_) { m[cb_] = -1e30f; l[cb_] = 0.f; _Pragma("unroll") for (int c_ = 0; c_ < 4; ++c_) o[cb_][c_] = (f32x4){0.f, 0.f, 0.f, 0.f}; } } while (0)
constexpr int F2R_BYTES = 16 * 68 * 4;
__device__ __forceinline__ void frag_to_rows(const f32x4 (&o)[4], f32x4 (&t)[4], LAS float* scr, int i16, int g) {
#pragma unroll
    for (int c = 0; c < 4; ++c) *(LAS f32x4*)(scr + i16 * 68 + 16 * c + 4 * g) = o[c];
    LDS_WAIT(); asm volatile("" ::: "memory");
#pragma unroll
    for (int q = 0; q < 4; ++q) t[q] = *(const LAS f32x4*)(scr + i16 * 68 + 16 * g + 4 * q);
    LDS_WAIT(); asm volatile("" ::: "memory");
}
__device__ __forceinline__ void store_row16_bf16(bf16_t* p, const f32x4 (&t)[4]) {
    u32x4 a, b; a.x = cvt_pk_bf16(t[0][0], t[0][1]); a.y = cvt_pk_bf16(t[0][2], t[0][3]); a.z = cvt_pk_bf16(t[1][0], t[1][1]); a.w = cvt_pk_bf16(t[1][2], t[1][3]);
    b.x = cvt_pk_bf16(t[2][0], t[2][1]); b.y = cvt_pk_bf16(t[2][2], t[2][3]); b.z = cvt_pk_bf16(t[3][0], t[3][1]); b.w = cvt_pk_bf16(t[3][2], t[3][3]);
    *(u32x4*)p = a; *(u32x4*)(p + 8) = b;
}
__device__ __forceinline__ float quad_sum(float v) { v += __shfl_xor(v, 16); v += __shfl_xor(v, 32); return v; }

__device__ __forceinline__ void swa_unit(int u, const bf16_t* PROJ, const float* BT, const float* sinks, bf16_t* AO, LAS unsigned char* lds, int tid, int lane, int wave) {
    const int b = u >> 8, kvh = (u >> 7) & 1, t0 = (u & 127) * 32, head = kvh * 8 + wave, i16 = lane & 15, g = lane >> 4;
    LAS float* lb = (LAS float*)lds; LAS unsigned char* KV = lds + 32768;
    const bf16_t* prow = PROJ + (size_t)(b * SEQ) * NP;
    const bf16_t* kbase = prow + C_KB + kvh * 64; const bf16_t* vbase = prow + C_VB + kvh * 64;
    const int kt0 = max(t0 - 127, 0) >> 6, kt1 = (t0 + 31) >> 6;
    bf16x8 qf[2][2];
#pragma unroll
    for (int cb = 0; cb < 2; ++cb)
#pragma unroll
        for (int s = 0; s < 2; ++s) qf[cb][s] = *(const bf16x8*)(prow + (size_t)(t0 + 16 * cb + i16) * NP + C_QB + head * 64 + 32 * s + 8 * g);
    __syncthreads();
    if (tid < 256) ((LAS f32x4*)lb)[tid] = *(const f32x4*)(BT + (16 + kvh * 8 + (tid >> 5)) * 1024 + 896 + 4 * (tid & 31));
    asm volatile("s_waitcnt vmcnt(0)" ::: "memory");
    const int nt = kt1 - kt0 + 1;
    for (int p = 0; p < 2 && p < nt; ++p) dma_tile(KV + p * 2 * TILE_U, kbase + (size_t)((kt0 + p) * 64) * NP, vbase + (size_t)((kt0 + p) * 64) * NP, NP, lane, wave);
    f32x4 o[2][4]; float m[2], l[2]; FLASH_INIT(o, m, l);
    for (int i = 0; i < nt; i += 2) {
        RING_PAIR_BARRIER();
        for (int h = 2; h < 4; ++h) if (i + h < nt) dma_tile(KV + ((i + h) & 3) * 2 * TILE_U, kbase + (size_t)((kt0 + i + h) * 64) * NP, vbase + (size_t)((kt0 + i + h) * 64) * NP, NP, lane, wave);
#pragma unroll 1
        for (int h = 0; h < 2; ++h) { if (i + h >= nt) break;
            const LAS unsigned char* Kt = KV + ((i + h) & 3) * 2 * TILE_U; const int kp0 = (kt0 + i + h) * 64;
            if (kp0 + 63 <= t0 && t0 + 31 - kp0 <= 127) flash_tile<0, 1>(Kt, Kt + TILE_U, lb + wave * 128, qf, o, m, l, t0, kp0, 128, 0ull, 0ull, 0, 127, lane);
            else flash_tile<0, 0>(Kt, Kt + TILE_U, lb + wave * 128, qf, o, m, l, t0, kp0, 128, 0ull, 0ull, 0, 127, lane); }
    }
    const float sk = sinks[head] * LOG2E;
    __syncthreads();
    LAS float* scr = (LAS float*)(KV + wave * F2R_BYTES);
#pragma unroll
    for (int cb = 0; cb < 2; ++cb) {
        const float lt = quad_sum(l[cb]); const float inv = 1.0f / (lt + __builtin_amdgcn_exp2f(sk - m[cb]));
        f32x4 v[4], t[4];
#pragma unroll
        for (int c = 0; c < 4; ++c) v[c] = o[cb][c] * inv;
        frag_to_rows(v, t, scr, i16, g);
        store_row16_bf16(AO + (size_t)(b * SEQ + t0 + 16 * cb + i16) * DM + 1024 + head * 64 + 16 * g, t);
    }
}

__device__ __forceinline__ void nsaw_unit(int u, const bf16_t* PROJ, const float* BT, bf16_t* OW, LAS unsigned char* lds, int tid, int lane, int wave) {
    const int b = u >> 8, kvh = (u >> 6) & 3, t0 = (u & 63) * 64, hl = wave & 3, head = kvh * 4 + hl, tq0 = t0 + 32 * (wave >> 2), i16 = lane & 15, g = lane >> 4;
    LAS float* lb = (LAS float*)lds; LAS unsigned char* KV = lds + 32768;
    const bf16_t* prow = PROJ + (size_t)(b * SEQ) * NP;
    const bf16_t* kbase = prow + C_KW + kvh * 64; const bf16_t* vbase = prow + C_VW + kvh * 64;
    const int kt0 = max(t0 - 511, 0) >> 6, kt1 = (t0 + 63) >> 6;
    bf16x8 qf[2][2];
#pragma unroll
    for (int cb = 0; cb < 2; ++cb)
#pragma unroll
        for (int s = 0; s < 2; ++s) qf[cb][s] = *(const bf16x8*)(prow + (size_t)(tq0 + 16 * cb + i16) * NP + C_QA + head * 64 + 32 * s + 8 * g);
    __syncthreads();
    { const f32x4* bsrc = (const f32x4*)(BT + kvh * 4 * 1024); ((LAS f32x4*)lb)[tid] = bsrc[tid]; ((LAS f32x4*)lb)[tid + 512] = bsrc[tid + 512]; }
    asm volatile("s_waitcnt vmcnt(0)" ::: "memory");
    const int nt = kt1 - kt0 + 1;
    for (int p = 0; p < 2 && p < nt; ++p) dma_tile(KV + p * 2 * TILE_U, kbase + (size_t)((kt0 + p) * 64) * NP, vbase + (size_t)((kt0 + p) * 64) * NP, NP, lane, wave);
    f32x4 o[2][4]; float m[2], l[2]; FLASH_INIT(o, m, l);
    for (int i = 0; i < nt; i += 2) {
        RING_PAIR_BARRIER();
        for (int h = 2; h < 4; ++h) if (i + h < nt) dma_tile(KV + ((i + h) & 3) * 2 * TILE_U, kbase + (size_t)((kt0 + i + h) * 64) * NP, vbase + (size_t)((kt0 + i + h) * 64) * NP, NP, lane, wave);
#pragma unroll 1
        for (int h = 0; h < 2; ++h) { if (i + h >= nt) break;
            const LAS unsigned char* Kt = KV + ((i + h) & 3) * 2 * TILE_U; const int kp0 = (kt0 + i + h) * 64;
            if (kp0 + 63 <= tq0 && tq0 + 31 - kp0 <= 511) flash_tile<0, 1>(Kt, Kt + TILE_U, lb + hl * 1024, qf, o, m, l, tq0, kp0, 512, 0ull, 0ull, 0, 1023, lane);
            else flash_tile<0, 0>(Kt, Kt + TILE_U, lb + hl * 1024, qf, o, m, l, tq0, kp0, 512, 0ull, 0ull, 0, 1023, lane); }
    }
    __syncthreads();
    LAS float* scr = (LAS float*)(KV + wave * F2R_BYTES);
#pragma unroll
    for (int cb = 0; cb < 2; ++cb) {
        const float lt = quad_sum(l[cb]); const float inv = lt > 0.f ? 1.0f / lt : 0.f;
        f32x4 v[4], t[4];
#pragma unroll
        for (int c = 0; c < 4; ++c) v[c] = o[cb][c] * inv;
        frag_to_rows(v, t, scr, i16, g);
        store_row16_bf16(OW + (size_t)(b * SEQ + tq0 + 16 * cb + i16) * 1024 + head * 64 + 16 * g, t);
    }
}

__device__ __forceinline__ float gelu_tanh(float x) {
    const float y = 0.7978845608028654f * (x + 0.044715f * x * x * x);
    const float e = __expf(2.0f * y);
    const float th = 1.0f - 2.0f / (e + 1.0f);
    return 0.5f * x * (1.0f + th);
}

__device__ __forceinline__ void compress_unit(int u, const bf16_t* PROJ, int ccol, const bf16_t* W1T, const bf16_t* W2T, const float* cbp, bf16_t* OUT,
                                              LAS unsigned char* lds, int tid, int lane, int wave) {
    const int i16 = lane & 15, g = lane >> 4, bh = u >> 4, ti = u & 15, tbase = 256 * ti;
    const bf16_t* src = PROJ + (size_t)((bh >> 2) * SEQ) * NP + ccol + (bh & 3) * 64;
    LAS unsigned char* slab = lds; LAS bf16_t* H = (LAS bf16_t*)(lds + 36864);
    __syncthreads();
    { u32x4 tmp[5];
#pragma unroll
      for (int k = 0; k < 5; ++k) { const int q = tid + 512 * k, r = q >> 3, ch = q & 7, tok = min(tbase + r, SEQ - 1); if (q < 272 * 8) tmp[k] = *(const u32x4*)(src + (size_t)tok * NP + ch * 8); }
#pragma unroll
      for (int k = 0; k < 5; ++k) { const int q = tid + 512 * k, r = q >> 3, ch = q & 7; if (q < 272 * 8) *(LAS u32x4*)(slab + r * 128 + ((ch ^ ((r >> 4) & 7)) << 4)) = tmp[k]; } }
    const bf16_t* b0 = W1T + (size_t)(32 * wave + i16) * 2048 + 8 * g; const bf16_t* b1 = b0 + 16 * 2048;
    f32x4 acc0 = {0.f, 0.f, 0.f, 0.f}, acc1 = {0.f, 0.f, 0.f, 0.f};
    __syncthreads();
#pragma unroll 8
    for (int kk = 0; kk < 64; ++kk) {
        const int r = 16 * i16 + (kk >> 1), chunk = 4 * (kk & 1) + g;
        const bf16x8 a = *(const LAS bf16x8*)(slab + r * 128 + ((chunk ^ ((r >> 4) & 7)) << 4));
        const bf16x8 w0 = *(const bf16x8*)(b0 + 32 * kk), w1 = *(const bf16x8*)(b1 + 32 * kk);
        acc0 = mfma16(a, w0, acc0); acc1 = mfma16(a, w1, acc1);
    }
#pragma unroll
    for (int nb = 0; nb < 2; ++nb) { const int n = 32 * wave + 16 * nb + i16; float cbv = 0.f;
#pragma unroll
        for (int q = 0; q < 32; ++q) cbv += cbp[q * 256 + n];
#pragma unroll
        for (int r = 0; r < 4; ++r) { const float x = (nb ? acc1[r] : acc0[r]) + cbv; H[(4 * g + r) * 264 + n] = f2bf1(gelu_tanh(x)); } }
    __syncthreads();
    if (wave < 4) {
        f32x4 acc = {0.f, 0.f, 0.f, 0.f};
#pragma unroll
        for (int ks = 0; ks < 8; ++ks) { const bf16x8 a = *(const LAS bf16x8*)(H + i16 * 264 + 32 * ks + 8 * g); const bf16x8 w = *(const bf16x8*)(W2T + (size_t)(16 * wave + i16) * 256 + 32 * ks + 8 * g); acc = mfma16(a, w, acc); }
#pragma unroll
        for (int r = 0; r < 4; ++r) { const int c2 = 16 * ti + 4 * g + r; OUT[(size_t)(bh * 256 + c2) * 64 + 16 * wave + i16] = c2 < 255 ? f2bf1(acc[r]) : (unsigned short)0; }
    }
}

__device__ __forceinline__ void nsa_unit(int u, const bf16_t* PROJ, const float* BT, const bf16_t* KC, const bf16_t* VC, const bf16_t* OW, float* OCB, bf16_t* AO,
                                         LAS unsigned char* lds, int tid, int lane, int wave) {
    const int b = u >> 8, kvh = (u >> 6) & 3, qt = u & 63, t0 = qt * 64;
    const int i16 = lane & 15, g = lane >> 4, hl = i16 & 3, head = kvh * 4 + hl, tq0 = t0 + 8 * wave, tl = i16 >> 2;
    LAS float* lb = (LAS float*)lds;
    LAS unsigned char* KCt = lds + 16384;
    LAS unsigned char* VCt = KCt + 4 * TILE_U;
    LAS float* IMP = (LAS float*)VCt;
    LAS unsigned long long* MASK = (LAS unsigned long long*)(VCt + 65536);
    const LAS float* lbh = lb + hl * 1024;
    __syncthreads();
    { const f32x4* bsrc = (const f32x4*)(BT + kvh * 4 * 1024); ((LAS f32x4*)lb)[tid] = bsrc[tid]; ((LAS f32x4*)lb)[tid + 512] = bsrc[tid + 512]; }
    const int cmax = min((t0 + 32) >> 4, 254), nct = (cmax >> 6) + 1;
    const bf16_t* kcb = KC + (size_t)((b * 4 + kvh) * 256) * 64; const bf16_t* vcb = VC + (size_t)((b * 4 + kvh) * 256) * 64;
    { const int rl = lane >> 3, cch = (lane & 7) ^ rl; const size_t goff = (size_t)(8 * wave + rl) * 64 + cch * 8;
      for (int kt = 0; kt < nct; ++kt) {
        __builtin_amdgcn_global_load_lds((const unsigned*)(kcb + kt * 4096 + goff), (LAS unsigned*)(KCt + kt * TILE_U + wave * 1024), 16, 0, 0);
        __builtin_amdgcn_global_load_lds((const unsigned*)(vcb + kt * 4096 + goff), (LAS unsigned*)(VCt + kt * TILE_U + wave * 1024), 16, 0, 0); } }
    const bf16_t* prow = PROJ + (size_t)(b * SEQ) * NP;
    bf16x8 qf[2][2];
#pragma unroll
    for (int cb = 0; cb < 2; ++cb)
#pragma unroll
        for (int s = 0; s < 2; ++s) qf[cb][s] = *(const bf16x8*)(prow + (size_t)(tq0 + 4 * cb + tl) * NP + C_QA + head * 64 + 32 * s + 8 * g);
    f32x4 o[2][4]; float m[2], l[2]; FLASH_INIT(o, m, l);
    asm volatile("s_waitcnt vmcnt(0)" ::: "memory");
    __syncthreads();
    for (int kt = 0; kt < nct; ++kt) {
        const int kp0 = kt * 64, dmin = tq0 - (16 * (kp0 + 63) + 31);
        if (kt < 3 && dmin >= 790) flash_tile<2, 2, 2>(KCt + kt * TILE_U, VCt + kt * TILE_U, lbh, qf, o, m, l, tq0, kp0, 0, 0ull, 0ull, 0, 1023, lane);
        else if (kt < 3 && dmin >= 0 && tq0 + 7 - 16 * kp0 - 31 <= 1023) flash_tile<2, 1, 2>(KCt + kt * TILE_U, VCt + kt * TILE_U, lbh, qf, o, m, l, tq0, kp0, 0, 0ull, 0ull, 0, 1023, lane);
        else flash_tile<2, 0, 2>(KCt + kt * TILE_U, VCt + kt * TILE_U, lbh, qf, o, m, l, tq0, kp0, 0, 0ull, 0ull, 0, 1023, lane);
    }
    float invl[2];
    float* const ocl = OCB + (size_t)(u * 8 + wave) * 2048 + lane * 4;
#pragma unroll
    for (int cb = 0; cb < 2; ++cb) { const float lt = quad_sum(l[cb]); invl[cb] = lt > 0.f ? 1.0f / lt : 0.f;
        const size_t row = (size_t)(b * SEQ + tq0 + 4 * cb + tl);
        const float g0 = 1.0f / (1.0f + __expf(-bf2f(PROJ[row * NP + C_GATE + 3 * head])));
#pragma unroll
        for (int c = 0; c < 4; ++c) *(f32x4*)(ocl + cb * 1024 + 256 * c) = o[cb][c] * (invl[cb] * g0);
    }
    __syncthreads();
    float cprev[2] = {0.f, 0.f};
    for (int kt = 0; kt < 4; ++kt) {
        const int kp0c = kt * 64, dminc = tq0 - (16 * (kp0c + 63) + 31);
        const int pth = (kt < 3 && dminc >= 790) ? 2 : ((kt < 3 && dminc >= 0 && tq0 + 7 - 16 * kp0c - 31 <= 1023) ? 1 : 0);
#pragma unroll 1
        for (int kb = 0; kb < 4; ++kb) {
            float own[2] = {0.f, 0.f}, car[2] = {0.f, 0.f};
            if (kt < nct) {
                const LAS unsigned char* kr = KCt + kt * TILE_U + (16 * kb + i16) * 128;
                const bf16x8 a0 = *(const LAS bf16x8*)(kr + ((g ^ (i16 & 7)) << 4)), a1 = *(const LAS bf16x8*)(kr + (((4 + g) ^ (i16 & 7)) << 4));
#pragma unroll
                for (int cb = 0; cb < 2; ++cb) {
                    f32x4 z = {0.f, 0.f, 0.f, 0.f}; z = mfma16(a0, qf[cb][0], z); z = mfma16(a1, qf[cb][1], z);
                    const int tq = tq0 + 4 * cb + tl;
                    if (pth != 0) {
                        f32x4 b4;
                        if (pth == 1) { const LAS float* pb = lbh + (1023 - tq + 31 + 16 * kp0c + 64 * g) + 256 * kb; b4 = (f32x4){pb[0], pb[16], pb[32], pb[48]}; }
                        else { const float bc = lbh[0]; b4 = (f32x4){bc, bc, bc, bc}; }
                        const f32x4 t4 = z * SCL2 + b4; const float mm = m[cb], il = invl[cb];
                        const float p0 = __builtin_amdgcn_exp2f(t4[0] - mm) * il, p1 = __builtin_amdgcn_exp2f(t4[1] - mm) * il, p2 = __builtin_amdgcn_exp2f(t4[2] - mm) * il, p3 = __builtin_amdgcn_exp2f(t4[3] - mm) * il;
                        own[cb] = (p0 + p1) + (p2 + p3); car[cb] = p3;
                    } else {
#pragma unroll
                        for (int r = 0; r < 4; ++r) { const int cc = kt * 64 + 16 * kb + 4 * g + r; const int dist = tq - (16 * cc + 31); const bool valid = dist >= 0 && cc < 255;
                            const float t = z[r] * SCL2 + lbh[1023 - min(max(dist, 0), 1023)];
                            const float pv = valid ? __builtin_amdgcn_exp2f(t - m[cb]) * invl[cb] : 0.f;
                            own[cb] += pv; if (r == 3) car[cb] = pv; }
                    }
                }
            }
#pragma unroll
            for (int cb = 0; cb < 2; ++cb) {
                const float send = (g == 3) ? cprev[cb] : car[cb];
                const float recv = __shfl(send, (lane + 48) & 63);
                cprev[cb] = car[cb];
                IMP[(hl * 64 + 8 * wave + 4 * cb + tl) * 64 + 4 * (4 * kt + kb) + g] = own[cb] + recv;
            }
        }
    }
    __syncthreads();
    for (int tt = 0; tt < 8; ++tt) {
        const int tok = 8 * wave + tt;
        float v = ((IMP[(0 * 64 + tok) * 64 + lane] + IMP[(1 * 64 + tok) * 64 + lane]) + IMP[(2 * 64 + tok) * 64 + lane]) + IMP[(3 * 64 + tok) * 64 + lane];
        const bool forced = lane == 0 || lane == qt || lane == qt - 1;
        v = forced ? v + 1e6f : v; v = lane > qt ? -1e30f : v;
        const unsigned ub = __float_as_uint(v); const unsigned key = (ub & 0x80000000u) ? ~ub : (ub | 0x80000000u);
        unsigned thr = 0u;
#pragma unroll
        for (int bit = 31; bit >= 0; --bit) { const unsigned cand = thr | (1u << bit); if (__popcll(__ballot(key >= cand)) >= 16) thr = cand; }
        const unsigned long long eq = __ballot(key == thr);
        const int need = 16 - __popcll(__ballot(key > thr));
        const int below = __builtin_amdgcn_mbcnt_hi((unsigned)(eq >> 32), __builtin_amdgcn_mbcnt_lo((unsigned)eq, 0u));
        const bool sel = key > thr || (key == thr && below < need);
        const unsigned long long mk = __ballot(sel && lane <= qt);
        if (lane == 0) MASK[tok] = mk;
    }
    __syncthreads();
    unsigned long long um = MASK[lane];
    { unsigned lo = (unsigned)um, hi = (unsigned)(um >> 32);
#pragma unroll
      for (int off = 1; off < 64; off <<= 1) { lo |= __shfl_xor(lo, off); hi |= __shfl_xor(hi, off); }
      lo = __builtin_amdgcn_readfirstlane(lo); hi = __builtin_amdgcn_readfirstlane(hi); um = ((unsigned long long)hi << 32) | lo; }
    const unsigned long long mk0 = MASK[8 * wave + tl], mk1 = MASK[8 * wave + 4 + tl];
    const unsigned long long um_all = um;
    for (int rs_ = 0; rs_ < REP_SEL; ++rs_) {
    um = um_all; FLASH_INIT(o, m, l);
    {
        const bf16_t* kbase = prow + C_KS + kvh * 64; const bf16_t* vbase = prow + C_VS + kvh * 64;
        LAS unsigned char* ring = KCt;
        unsigned long long ui = um;
        const int nt = __builtin_popcountll(um);
        asm volatile("s_waitcnt vmcnt(0)" ::: "memory");
        for (int p = 0; p < 2 && p < nt; ++p) { const int jj = __builtin_ctzll(ui); ui &= ui - 1ull; dma_tile(ring + p * 2 * TILE_U, kbase + (size_t)(64 * jj) * NP, vbase + (size_t)(64 * jj) * NP, NP, lane, wave); }
        for (int i = 0; i < nt; i += 2) {
            RING_PAIR_BARRIER();
            for (int h = 2; h < 4; ++h) if (ui) { const int jj = __builtin_ctzll(ui); ui &= ui - 1ull; dma_tile(ring + ((i + h) & 3) * 2 * TILE_U, kbase + (size_t)(64 * jj) * NP, vbase + (size_t)(64 * jj) * NP, NP, lane, wave); }
#pragma unroll 1
            for (int h = 0; h < 2; ++h) { if (i + h >= nt) break;
                const int j = __builtin_ctzll(um); um &= um - 1ull;
                const LAS unsigned char* Kt = ring + ((i + h) & 3) * 2 * TILE_U; const int kp0 = 64 * j;
                if (tq0 - (kp0 + 63) >= 790) flash_tile<1, 2, 2>(Kt, Kt + TILE_U, lbh, qf, o, m, l, tq0, kp0, 0, mk0, mk1, j, 1023, lane);
                else if (kp0 + 63 <= tq0 && tq0 + 7 - kp0 <= 1023) flash_tile<1, 1, 2>(Kt, Kt + TILE_U, lbh, qf, o, m, l, tq0, kp0, 0, mk0, mk1, j, 1023, lane);
                else flash_tile<1, 0, 2>(Kt, Kt + TILE_U, lbh, qf, o, m, l, tq0, kp0, 0, mk0, mk1, j, 1023, lane); }
        }
    }
    }
    __syncthreads();
    LAS float* scr = (LAS float*)(KCt + wave * F2R_BYTES);
#pragma unroll
    for (int cb = 0; cb < 2; ++cb) {
        const size_t row = (size_t)(b * SEQ + tq0 + 4 * cb + tl);
        const bf16_t* gp = PROJ + row * NP + C_GATE + 3 * head;
        const float g1 = 1.0f / (1.0f + __expf(-bf2f(gp[1]))), g2 = 1.0f / (1.0f + __expf(-bf2f(gp[2])));
        const float lt = quad_sum(l[cb]); const float inv = (lt > 0.f ? 1.0f / lt : 0.f) * g1;
        f32x4 v[4], t[4];
#pragma unroll
        for (int c = 0; c < 4; ++c) v[c] = *(const f32x4*)(ocl + cb * 1024 + 256 * c) + o[cb][c] * inv;
        frag_to_rows(v, t, scr, i16, g);
        const bf16_t* wp = OW + row * 1024 + head * 64 + 16 * g;
        const u32x4 wa = *(const u32x4*)wp, wb = *(const u32x4*)(wp + 8);
        const unsigned wu[8] = {wa.x, wa.y, wa.z, wa.w, wb.x, wb.y, wb.z, wb.w};
#pragma unroll
        for (int q = 0; q < 4; ++q) { t[q][0] += g2 * __uint_as_float(wu[2 * q] << 16); t[q][1] += g2 * __uint_as_float(wu[2 * q] & 0xffff0000u);
            t[q][2] += g2 * __uint_as_float(wu[2 * q + 1] << 16); t[q][3] += g2 * __uint_as_float(wu[2 * q + 1] & 0xffff0000u); }
        store_row16_bf16(AO + row * DM + head * 64 + 16 * g, t);
    }
}

#define RLX_AGENT __ATOMIC_RELAXED, __HIP_MEMORY_SCOPE_AGENT
#define XB_TMO      128
#define XB_XCNT(j)  (256  + 64 * (j))
#define XB_XSUB(j)  (1280 + 64 * (j))
#define XB_XGEN(j)  (2304 + 64 * (j))
#define XB_TOP      3328
#define XB_TOPGEN   3392
#define XCD_BAR_WORDS 3456
#define XB_SPIN_CAP (1u << 18)

__device__ __forceinline__ unsigned xb_ld(unsigned* p)              { return __hip_atomic_load(p, __ATOMIC_RELAXED, __HIP_MEMORY_SCOPE_AGENT); }
__device__ __forceinline__ unsigned xb_add(unsigned* p, unsigned v) { return __hip_atomic_fetch_add(p, v, __ATOMIC_RELAXED, __HIP_MEMORY_SCOPE_AGENT); }
__device__ __forceinline__ unsigned xb_xcc_id() { return (unsigned)__builtin_amdgcn_s_getreg((3 << 11) | 20) & 0xFu; }
#define XB_SPIN(cond, bar) do { unsigned _sp = 0; while (cond) { __builtin_amdgcn_s_sleep(1); \
    if ((++_sp & 255u) == 0u) { if (xb_ld(&(bar)[XB_TMO])) break; if (_sp > XB_SPIN_CAP) { atomicAdd(&(bar)[XB_TMO], 1u); break; } } } } while (0)

struct XcdBarrier {
    unsigned* bar; unsigned x;
    volatile LAS unsigned* st;
};

__device__ __forceinline__ XcdBarrier xcd_barrier_post(unsigned* bar, volatile LAS unsigned* st) {
    XcdBarrier b; b.bar = bar; b.x = xb_xcc_id(); b.st = st;
    if (threadIdx.x == 0) (void)xb_add(&bar[XB_XCNT(b.x)], 1u);
    return b;
}
__device__ __forceinline__ void xcd_barrier_complete(unsigned* bar, unsigned x, unsigned& nloc, unsigned& nx) {
    const unsigned G = gridDim.x * gridDim.y * gridDim.z;
    unsigned sum, cnt, mine, sp = 0u;
    for (;;) {
        sum = 0u; cnt = 0u; mine = 0u;
#pragma unroll
        for (unsigned j = 0; j < 16; ++j) { const unsigned c = xb_ld(&bar[XB_XCNT(j)]); sum += c; cnt += (c > 0u) ? 1u : 0u; mine = (j == x) ? c : mine; }
        if (sum == G) break;
        __builtin_amdgcn_s_sleep(1);
        if ((++sp & 255u) == 0u) { if (xb_ld(&bar[XB_TMO])) break; if (sp > XB_SPIN_CAP) { atomicAdd(&bar[XB_TMO], 1u); break; } }
    }
    nloc = mine > 0u ? mine : 1u; nx = cnt > 0u ? cnt : 1u;
}

__device__ __forceinline__ void xcd_barrier(const XcdBarrier& b) {
    asm volatile("s_waitcnt vmcnt(0)" ::: "memory");
    __syncthreads();
    if (threadIdx.x == 0) {
        unsigned* bar = b.bar;
        __builtin_amdgcn_s_waitcnt(0);
        unsigned nloc = b.st[0], nx = b.st[1];
        if (nloc == 0u) { xcd_barrier_complete(bar, b.x, nloc, nx); b.st[0] = nloc; b.st[1] = nx; }
        const unsigned old = xb_add(&bar[XB_XSUB(b.x)], 1u);
        const unsigned gen = old / nloc;
        if (old + 1u == (gen + 1u) * nloc) {
            __builtin_amdgcn_fence(__ATOMIC_RELEASE, "agent");
            asm volatile("s_waitcnt vmcnt(0)" ::: "memory");
            const unsigned og = xb_add(&bar[XB_TOP], 1u);
            const unsigned tg = og / nx;
            if (og + 1u == (tg + 1u) * nx) xb_add(&bar[XB_TOPGEN], 1u);
            else XB_SPIN(xb_ld(&bar[XB_TOPGEN]) == tg, bar);
            __builtin_amdgcn_fence(__ATOMIC_ACQUIRE, "agent");
            xb_add(&bar[XB_XGEN(b.x)], 1u);
            asm volatile("s_waitcnt vmcnt(0)" ::: "memory");
        } else {
            XB_SPIN(xb_ld(&bar[XB_XGEN(b.x)]) == gen, bar);
            __builtin_amdgcn_fence(__ATOMIC_ACQUIRE, "agent");
            asm volatile("s_waitcnt vmcnt(0)" ::: "memory");
        }
    }
    __syncthreads();
}

constexpr int REP_A = 1, REP_C = 1, REP_D = 1, REP_G = 1, REP_S = 0;
#define PHASE_BEGIN \
    PP Pp = (PP)__builtin_amdgcn_kernarg_segment_ptr(); asm volatile("" : "+s"(Pp)); \
    int tid_ = threadIdx.x; asm volatile("" : "+v"(tid_)); \
    const int tid = tid_, lane = tid & 63, wave = __builtin_amdgcn_readfirstlane(tid >> 6), gw = bx * 8 + wave; (void)gw; (void)lane; \
    unsigned char* const ws = Pp->ws; (void)ws

__global__ void __launch_bounds__(512, 2) mega_fwd(Params P_unused) {
    extern __shared__ __attribute__((aligned(16))) unsigned char lds_raw[];
    LAS unsigned char* lds = (LAS unsigned char*)lds_raw;
    cg::grid_group grid = cg::this_grid();
    const int G = gridDim.x, bx = blockIdx.x, ngw = G * 8;
    { volatile LAS unsigned* st0 = (volatile LAS unsigned*)(lds + MISC_OFF); if (threadIdx.x < 2) st0[threadIdx.x] = 0u; }
    if (bx == 0) { PP Pq = (PP)__builtin_amdgcn_kernarg_segment_ptr(); unsigned* bw = (unsigned*)(Pq->ws + WS_BAR); for (int i = threadIdx.x; i < XCD_BAR_WORDS; i += 512) bw[i] = 0u; }
    __syncthreads();
    XcdBarrier xbar; xbar.bar = nullptr; xbar.x = 0u; xbar.st = nullptr;
#define GRID_SYNC() xcd_barrier(xbar)

    { PHASE_BEGIN; prep_phase(Pp, 0, lds, gw, ngw, tid, lane, wave);
      rows_bf16_ssq(Pp->in[0], Pp->in[2], (bf16_t*)(ws + WS_XN), (float*)(ws + WS_SSQ), gw, ngw, lane); }
    grid.sync();
    { PP Pq = (PP)__builtin_amdgcn_kernarg_segment_ptr(); xbar = xcd_barrier_post((unsigned*)(Pq->ws + WS_BAR), (volatile LAS unsigned*)(lds + MISC_OFF)); }
    for (int L = 0; L < DEPTH; ++L) {
#if !defined(ONLY) || ONLY == 1
        { PHASE_BEGIN;
          pg8::Gemm gm{(const bf16_t*)(ws + WS_XN), (const bf16_t*)(ws + WS_WIN), MTOK, NP, DM}; pg8::StaticOrder S; S.init(MTOK, NP, G, bx);
          pg8::EpiProjN E{0};
          pg8::gemm_phase<pg8::EpiProjN, pg8::StaticOrder, true, true>(lds, gm, S, E); }
#endif
        GRID_SYNC();
#if !defined(ONLY) || ONLY == 2
        for (int rep_ = 0; rep_ < REP_C; ++rep_) {
        { PHASE_BEGIN;
          const bf16_t* PROJ = (const bf16_t*)(ws + WS_PROJ); const float* BT = (const float*)(ws + WS_BT);
          for (int it = bx; it < 1280; it += G) {
            int kind, uu;
            if (G == 256) { const int k = it >> 8, x = bx & 7, loc = bx >> 3;
                if (k == 0) { kind = 0; uu = ((loc >> 4) << 7) | (x * 16 + (loc & 15)); }
                else if (k <= 2) { kind = 1; uu = x * 64 + (k == 1 ? loc : 63 - loc); }
                else { kind = 2; uu = (x >> 1) * 128 + (x & 1) * 64 + (k == 3 ? loc : 63 - loc); } }
            else { kind = it < 256 ? 0 : (it < 768 ? 1 : 2); uu = it - (kind == 0 ? 0 : (kind == 1 ? 256 : 768)); }
            if (kind == 1) nsaw_unit(uu, PROJ, BT, (bf16_t*)(ws + WS_OW), lds, tid, lane, wave);
            else if (kind == 2) swa_unit(uu, PROJ, BT, Pp->in[12] + L * 16, (bf16_t*)(ws + WS_AO), lds, tid, lane, wave);
            else { const int cu = uu; const int mat = cu >> 7;
                compress_unit(cu & 127, PROJ, mat ? C_VC : C_KC, (const bf16_t*)(ws + (mat ? WS_C1V : WS_C1K)), (const bf16_t*)(ws + (mat ? WS_C2V : WS_C2K)),
                              (const float*)(ws + WS_CBP) + mat * 8192, (bf16_t*)(ws + (mat ? WS_VC : WS_KC)), lds, tid, lane, wave); }
          } }
        GRID_SYNC(); }
#endif
#if !defined(ONLY) || ONLY == 3
        for (int rep_ = 0; rep_ < REP_D; ++rep_) {
        { PHASE_BEGIN;
          for (int it = bx; it < 512; it += G) { const int u = G == 256 ? (bx & 7) * 64 + (it < 256 ? (bx >> 3) : 63 - (bx >> 3)) : (it < 256 ? it : 767 - it);
            nsa_unit(u, (const bf16_t*)(ws + WS_PROJ), (const float*)(ws + WS_BT), (const bf16_t*)(ws + WS_KC), (const bf16_t*)(ws + WS_VC), (const bf16_t*)(ws + WS_OW),
                     (float*)(ws + WS_OCB), (bf16_t*)(ws + WS_AO), lds, tid, lane, wave); } }
        GRID_SYNC(); }
#endif
        for (int rep_ = 0; rep_ < REP_S; ++rep_) GRID_SYNC();
#if !defined(ONLY) || ONLY == 4
        { PHASE_BEGIN;
          pg8::Gemm gm{(const bf16_t*)(ws + WS_AO), (const bf16_t*)(ws + WS_WOUT), MTOK, DM, DM}; pg8::StaticOrder S; S.init(MTOK, DM, G, bx);
          pg8::EpiResid E{L == 0, 3, L};
          pg8::gemm_phase<pg8::EpiResid, pg8::StaticOrder, true, true>(lds, gm, S, E); }
#endif
        GRID_SYNC();
#if !defined(ONLY) || ONLY == 6
        for (int rep_ = 0; rep_ < REP_G; ++rep_) {
        { PHASE_BEGIN;
          pg8::Gemm gm{(const bf16_t*)(ws + WS_XN), (const bf16_t*)(ws + ((L & 1) ? WS_WGU_B : WS_WGU)), MTOK, NGU, DM}; pg8::StaticOrder S; S.init(MTOK, NGU, G, bx);
          pg8::EpiSwiGLU E{0};
          pg8::gemm_phase<pg8::EpiSwiGLU, pg8::StaticOrder, true, true>(lds, gm, S, E);
          if (L + 1 < DEPTH && G == 256 && bx >= 128) { PHASE_BEGIN; prep_phase(Pp, L + 1, lds, (bx - 128) * 8 + wave, 128 * 8, tid, lane, wave, 0, PREP_EARLY, false); } }
        GRID_SYNC(); }
#endif
#if !defined(ONLY) || ONLY == 7
        { PHASE_BEGIN;
          pg8::Gemm gm{(const bf16_t*)(ws + WS_ACT), (const bf16_t*)(ws + ((L & 1) ? WS_WDN_B : WS_WDN)), MTOK, DM, DFF}; pg8::StaticOrder S; S.init(MTOK, DM, G, bx);
          pg8::EpiResid E{0, L == DEPTH - 1 ? 17 : 2, L == DEPTH - 1 ? 0 : L + 1, L == DEPTH - 1};
          pg8::gemm_phase<pg8::EpiResid, pg8::StaticOrder, true, true>(lds, gm, S, E);
          if (L + 1 < DEPTH) { PHASE_BEGIN; prep_phase(Pp, L + 1, lds, gw, ngw, tid, lane, wave, G == 256 ? PREP_EARLY : 0, PREP_NITEMS, true); } }
#endif
        GRID_SYNC();
    }
    { PHASE_BEGIN; norm_rows_f32((const float*)(ws + WS_X), Pp->in[17], Pp->out, gw, ngw, lane); }
}

extern "C" void kernel_launch(void* const* d_in, const int* in_sizes, int n_in, void* d_out, int out_size, void* d_ws, size_t ws_size, hipStream_t stream) {
    static int grid = 0;
    if (grid == 0) {
        if (n_in != 18 || ws_size < WS_END) { fprintf(stderr, "kernel_launch: unexpected n_in %d / ws_size %zu\n", n_in, ws_size); grid = -1; return; }
        int dev = 0, cus = 0, per_cu = 0;
        (void)hipGetDevice(&dev); (void)hipDeviceGetAttribute(&cus, hipDeviceAttributeMultiprocessorCount, dev);
        if (hipFuncSetAttribute((const void*)mega_fwd, hipFuncAttributeMaxDynamicSharedMemorySize, LDS_BYTES) != hipSuccess) fprintf(stderr, "kernel_launch: hipFuncSetAttribute failed\n");
        if (hipOccupancyMaxActiveBlocksPerMultiprocessor(&per_cu, (const void*)mega_fwd, 512, LDS_BYTES) != hipSuccess || per_cu < 1) { fprintf(stderr, "kernel_launch: occupancy query gave %d\n", per_cu); per_cu = 1; }
        (void)hipGetLastError();
        grid = cus * per_cu;
    }
    if (grid < 0) return;
    Params p{};
    for (int i = 0; i < 18; ++i) p.in[i] = (const float*)d_in[i];
    p.out = (float*)d_out; p.ws = (unsigned char*)d_ws;
    void* args[] = {&p};
    const hipError_t e = hipLaunchCooperativeKernel((const void*)mega_fwd, dim3(grid), dim3(512), args, LDS_BYTES, stream);
    if (e != hipSuccess) fprintf(stderr, "kernel_launch: cooperative launch failed: %s (grid %d)\n", hipGetErrorString(e), grid);
}
```

```cpp
#include <hip/hip_runtime.h>
#include <hip/hip_cooperative_groups.h>
#include <cstdio>
#include <cstdint>
namespace cg = cooperative_groups;
constexpr int SEQ = 4096, MTOK = 8192, DM = 2048, NPROJ = 3888, NP = 4096, DFF = 5632, NGU = 11264, DEPTH = 4;
constexpr int C_QA = 0, C_KC = 1024, C_VC = 1280, C_KS = 1536, C_VS = 1792, C_KW = 2048, C_VW = 2304, C_QB = 2560, C_KB = 3584, C_VB = 3712, C_GATE = 3840;
constexpr float LOG2E = 1.4426950408889634f;
constexpr float SCL2 = 0.125f * 1.4426950408889634f;
constexpr int LDS_BYTES = 147456, MISC_OFF = 131072 + 512;
constexpr int KSTR = 144;
constexpr int TILE_B = 64 * KSTR;

constexpr size_t MiB = 1u << 20;
constexpr size_t WS_BAR = 65536, WS_CTL_BYTES = 1 * MiB, WS_WIN = 1 * MiB, WS_WOUT = 17 * MiB, WS_WGU = 25 * MiB, WS_WDN = 69 * MiB, WS_C1K = 91 * MiB, WS_C1V = 92 * MiB,
                 WS_C2K = 93 * MiB, WS_C2V = 93 * MiB + 65536, WS_BIASP = 93 * MiB + 131072, WS_CBP = 93 * MiB + 196608, WS_BT = 93 * MiB + 262144,
                 WS_KC = 94 * MiB, WS_VC = 94 * MiB + 262144, WS_PROJ = 95 * MiB, WS_X = 159 * MiB, WS_XN = 223 * MiB, WS_AO = 255 * MiB,
                 WS_OW = 287 * MiB, WS_ACT = 303 * MiB, WS_OCB = 391 * MiB, WS_SSQ = 423 * MiB, WS_WDN_B = 424 * MiB, WS_WGU_B = 446 * MiB, WS_END = 490 * MiB;

struct Params { const float* in[18]; float* out; unsigned char* ws; };
typedef const __attribute__((address_space(4))) Params* PP;
#define KERNARGS(Pp) PP Pp = (PP)__builtin_amdgcn_kernarg_segment_ptr(); asm volatile("" : "+s"(Pp))
namespace pg8 {
#define PG8_LAS __attribute__((address_space(3)))
typedef unsigned short bf16_t;
typedef short bf16x8 __attribute__((ext_vector_type(8)));
typedef float f32x4 __attribute__((ext_vector_type(4)));
typedef unsigned u32x4 __attribute__((ext_vector_type(4)));
constexpr int BM = 256, BK = 64, HALF = 128, HTB = HALF * BK * 2  , STAGE_BYTES = 8 * HTB, NXCD = 8, WGM = 8;

__host__ __device__ __forceinline__ int lds_byte(int r, int c) { const int st = (r >> 4) * 2 + (c >> 5), rr = r & 15, cc = c & 31, ob = rr * 64 + cc * 2; return st * 1024 + (ob ^ (((ob >> 9) & 1) << 5)); }
__host__ __device__ __forceinline__ void stage_rc(int b, int& R, int& C) { const int st = b / 1024, sb = b % 1024, swz = sb ^ (((sb >> 9) & 1) << 5); R = (st >> 1) * 16 + swz / 64; C = (st & 1) * 32 + (swz % 64) / 2; }
__host__ __device__ __forceinline__ int perm32(int rho) { const int n = rho >> 4, i = rho & 15; return 8 * (i >> 2) + 4 * n + (i & 3); }

struct Unit { int pm, pn; };
struct Gemm { const bf16_t* A; const bf16_t* Bt; int M, N, K; };

struct StaticOrder {
    int nM, nN, nwg, G, c;
    __host__ __device__ void init(int M, int N, int G_, int c_) { nM = M / BM; nN = N / BM; nwg = nM * nN; G = G_; c = c_; }
    __host__ __device__ bool next(int i, Unit& u) const {
        const long L = (long)i * G + c; if (L >= nwg) return false;
        int wgid = (int)L; { const int q = nwg / NXCD, r = nwg % NXCD, xcd = wgid % NXCD, off = wgid / NXCD; wgid = (xcd < r ? xcd * (q + 1) : r * (q + 1) + (xcd - r) * q) + off; }
        const int nig = WGM * nN, gid = wgid / nig, fm = gid * WGM, gsz = (nM - fm) < WGM ? (nM - fm) : WGM;
        u.pm = fm + ((wgid % nig) % gsz); u.pn = (wgid % nig) / gsz; return true;
    }
    __device__ __forceinline__ void a_ready(const Unit&) const {}
    __device__ __forceinline__ void done(const Unit&) const {}
};

typedef float f32x2 __attribute__((ext_vector_type(2)));
typedef __bf16 bf16x2_t __attribute__((ext_vector_type(2)));
__device__ __forceinline__ unsigned cvt_pk_bf16(float lo, float hi) { const f32x2 v = {lo, hi}; const bf16x2_t b = __builtin_convertvector(v, bf16x2_t); return __builtin_bit_cast(unsigned, b); }
__device__ __forceinline__ f32x2 gelu_pk(f32x2 v) {
    const f32x2 av = __builtin_elementwise_abs(v), d = av * 0.2316418882f + 1.0f;
    f32x2 t; t.x = __builtin_amdgcn_rcpf(d.x); t.y = __builtin_amdgcn_rcpf(d.y);
    f32x2 q = t * 0.5307027145f + (-0.7265760135f); q = q * t + 0.7107068705f; q = q * t + (-0.142248368f); q = q * t + 0.127414796f; q = q * t;
    const f32x2 s = (v * v) * (-0.72134752044f);
    f32x2 e; e.x = __builtin_amdgcn_exp2f(s.x); e.y = __builtin_amdgcn_exp2f(s.y);
    const f32x2 m = v * (q * e), r = v - m;
    f32x2 o; o.x = v.x < 0.f ? m.x : r.x; o.y = v.y < 0.f ? m.y : r.y; return o;
}

template <int ACT  > struct EpiBf16 {
    static constexpr bool PERM = true, AFTER_DRAIN = false; static_assert(ACT == 0 || ACT == 1, "EpiBf16: ACT is 0 (none) or 1 (gelu_pk)");
    bf16_t* O; int ldc; const float* bias; int split_cols; size_t split_stride; float scale0;
    __device__ __forceinline__ void operator()(const f32x4 (&acc)[2][2][4][2], const Unit& u, int wr, int wc, int fr, int fq) const {
        const int row0 = u.pm * BM + wr * 64 + fr; int colt = u.pn * BM; bf16_t* base = O;
        float sc = 1.f; if (split_cols) { const int t = colt / split_cols; base += (size_t)t * split_stride; colt -= t * split_cols; if (t == 0) sc = scale0; }
        const int col0 = colt + wc * 32 + 8 * fq, bcol0 = u.pn * BM + wc * 32 + 8 * fq;
        f32x4 bv[2][2];
#pragma unroll
        for (int bj = 0; bj < 2; ++bj)
#pragma unroll
            for (int n = 0; n < 2; ++n) bv[bj][n] = bias ? *(const f32x4*)(bias + bcol0 + bj * HALF + 4 * n) : (f32x4){0.f, 0.f, 0.f, 0.f};
#pragma unroll
        for (int ai = 0; ai < 2; ++ai)
#pragma unroll
            for (int m = 0; m < 4; ++m) { bf16_t* rowp = base + (size_t)(row0 + ai * HALF + m * 16) * ldc + col0;
#pragma unroll
                for (int bj = 0; bj < 2; ++bj) { f32x4 v0 = acc[ai][bj][m][0] + bv[bj][0], v1 = acc[ai][bj][m][1] + bv[bj][1];
                    if (ACT == 1) { f32x2 a = gelu_pk((f32x2){v0[0], v0[1]}), b = gelu_pk((f32x2){v0[2], v0[3]}), c = gelu_pk((f32x2){v1[0], v1[1]}), d = gelu_pk((f32x2){v1[2], v1[3]});
                        v0 = (f32x4){a.x, a.y, b.x, b.y}; v1 = (f32x4){c.x, c.y, d.x, d.y}; }
                    v0 = v0 * sc; v1 = v1 * sc; u32x4 w; w.x = cvt_pk_bf16(v0[0], v0[1]); w.y = cvt_pk_bf16(v0[2], v0[3]); w.z = cvt_pk_bf16(v1[0], v1[1]); w.w = cvt_pk_bf16(v1[2], v1[3]);
                    *(u32x4*)(rowp + bj * HALF) = w; } }
    }
};

typedef unsigned u32x2 __attribute__((ext_vector_type(2)));
struct EpiResid {
    static constexpr bool PERM = true, AFTER_DRAIN = false;
    int l0, gi, gl, nocopy = 0;
    __device__ __forceinline__ void operator()(const f32x4 (&acc)[2][2][4][2], const Unit& u, int wr, int wc, int fr, int fq) const {
        KERNARGS(Pp); unsigned char* const ws = Pp->ws; const float* base = l0 ? Pp->in[0] : (const float*)(ws + WS_X); float* out = (float*)(ws + WS_X); bf16_t* xb = (bf16_t*)(ws + WS_XN); float* ssq = (float*)(ws + WS_SSQ); constexpr int ldc = DM;
        const int row0 = u.pm * BM + wr * 64 + fr, col0 = u.pn * BM + wc * 32 + 8 * fq;
        const float* gn = Pp->in[gi] + (size_t)gl * DM + col0; f32x4 gv[2][2];
#pragma unroll
        for (int bj = 0; bj < 2; ++bj) { gv[bj][0] = *(const f32x4*)(gn + bj * HALF); gv[bj][1] = *(const f32x4*)(gn + bj * HALF + 4); }
#pragma unroll
        for (int ai = 0; ai < 2; ++ai)
#pragma unroll
            for (int m = 0; m < 4; ++m) { const int row = row0 + ai * HALF + m * 16; const size_t off = (size_t)row * ldc + col0; float sq = 0.f;
#pragma unroll
                for (int bj = 0; bj < 2; ++bj) { const float* bp = base + off + bj * HALF; float* op = out + off + bj * HALF;
                    const f32x4 v0 = *(const f32x4*)bp + acc[ai][bj][m][0], v1 = *(const f32x4*)(bp + 4) + acc[ai][bj][m][1];
                    *(f32x4*)op = v0; *(f32x4*)(op + 4) = v1;
                    if (nocopy) continue;
                    const f32x4 h0 = v0 * gv[bj][0], h1 = v1 * gv[bj][1];
                    u32x4 w; w.x = cvt_pk_bf16(h0[0], h0[1]); w.y = cvt_pk_bf16(h0[2], h0[3]); w.z = cvt_pk_bf16(h1[0], h1[1]); w.w = cvt_pk_bf16(h1[2], h1[3]);
                    *(u32x4*)(xb + off + bj * HALF) = w;
                    sq += (v0[0] * v0[0] + v0[1] * v0[1]) + (v0[2] * v0[2] + v0[3] * v0[3]) + (v1[0] * v1[0] + v1[1] * v1[1]) + (v1[2] * v1[2] + v1[3] * v1[3]); }
                if (nocopy) continue;
                sq += __shfl_xor(sq, 16); sq += __shfl_xor(sq, 32);
                if (fq == 0) ssq[(size_t)row * 32 + u.pn * 4 + wc] = sq; }
    }
};
__device__ __forceinline__ void row_rinv(const float* ssq, int row0, int fq, float (&rinv)[2][4]) {
#pragma unroll
    for (int ai = 0; ai < 2; ++ai)
#pragma unroll
        for (int m = 0; m < 4; ++m) { const f32x4* p = (const f32x4*)(ssq + (size_t)(row0 + ai * HALF + m * 16) * 32) + 2 * fq; const f32x4 a = p[0] + p[1];
            float s = (a[0] + a[1]) + (a[2] + a[3]); s += __shfl_xor(s, 16); s += __shfl_xor(s, 32);
            rinv[ai][m] = __builtin_amdgcn_rsqf(s * (1.0f / 2048.0f) + 1e-5f); }
}
struct EpiProjN {
    static constexpr bool PERM = true, AFTER_DRAIN = false;
    int dummy;
    __device__ __forceinline__ void operator()(const f32x4 (&acc)[2][2][4][2], const Unit& u, int wr, int wc, int fr, int fq) const {
        KERNARGS(Pp); unsigned char* const ws = Pp->ws; bf16_t* O = (bf16_t*)(ws + WS_PROJ); constexpr int ldc = NP; const float* bias = (const float*)(ws + WS_BIASP); const float* ssq = (const float*)(ws + WS_SSQ);
        const int row0 = u.pm * BM + wr * 64 + fr, col0 = u.pn * BM + wc * 32 + 8 * fq;
        float rinv[2][4]; row_rinv(ssq, row0, fq, rinv);
        f32x4 bv[2][2];
#pragma unroll
        for (int bj = 0; bj < 2; ++bj)
#pragma unroll
            for (int n = 0; n < 2; ++n) bv[bj][n] = *(const f32x4*)(bias + col0 + bj * HALF + 4 * n);
#pragma unroll
        for (int ai = 0; ai < 2; ++ai)
#pragma unroll
            for (int m = 0; m < 4; ++m) { bf16_t* rowp = O + (size_t)(row0 + ai * HALF + m * 16) * ldc + col0; const float r = rinv[ai][m];
#pragma unroll
                for (int bj = 0; bj < 2; ++bj) { const f32x4 v0 = acc[ai][bj][m][0] * r + bv[bj][0], v1 = acc[ai][bj][m][1] * r + bv[bj][1];
                    u32x4 w; w.x = cvt_pk_bf16(v0[0], v0[1]); w.y = cvt_pk_bf16(v0[2], v0[3]); w.z = cvt_pk_bf16(v1[0], v1[1]); w.w = cvt_pk_bf16(v1[2], v1[3]);
                    *(u32x4*)(rowp + bj * HALF) = w; } }
    }
};
__device__ __forceinline__ float silu_f(float x) { return x * __builtin_amdgcn_rcpf(1.0f + __expf(-x)); }
struct EpiSwiGLU {
    static constexpr bool PERM = true, AFTER_DRAIN = false;
    int dummy;
    __device__ __forceinline__ void operator()(const f32x4 (&acc)[2][2][4][2], const Unit& u, int wr, int wc, int fr, int fq) const {
        KERNARGS(Pp); unsigned char* const ws = Pp->ws; bf16_t* O = (bf16_t*)(ws + WS_ACT); constexpr int ldc = DFF; const float* ssq = (const float*)(ws + WS_SSQ);
        const int row0 = u.pm * BM + wr * 64 + fr, colh = u.pn * (BM / 2) + wc * 32 + 8 * fq;
        float rinv[2][4]; row_rinv(ssq, row0, fq, rinv);
#pragma unroll
        for (int ai = 0; ai < 2; ++ai)
#pragma unroll
            for (int m = 0; m < 4; ++m) { bf16_t* rowp = O + (size_t)(row0 + ai * HALF + m * 16) * ldc + colh; const float r = rinv[ai][m];
                const f32x4 g0 = acc[ai][0][m][0] * r, g1 = acc[ai][0][m][1] * r, u0 = acc[ai][1][m][0] * r, u1 = acc[ai][1][m][1] * r;
                u32x4 w; w.x = cvt_pk_bf16(silu_f(g0[0]) * u0[0], silu_f(g0[1]) * u0[1]); w.y = cvt_pk_bf16(silu_f(g0[2]) * u0[2], silu_f(g0[3]) * u0[3]);
                w.z = cvt_pk_bf16(silu_f(g1[0]) * u1[0], silu_f(g1[1]) * u1[1]); w.w = cvt_pk_bf16(silu_f(g1[2]) * u1[2], silu_f(g1[3]) * u1[3]);
                *(u32x4*)rowp = w; }
    }
};
template <class Epi, class Sched, bool ALIGN_EPI = false, bool SP2 = false>
__device__ __forceinline__ void gemm_phase(PG8_LAS unsigned char* lds, const Gemm g, const Sched& S, const Epi& E) {
    int tid_o = threadIdx.x; asm volatile("" : "+v"(tid_o));
    const int tid = tid_o, wid = __builtin_amdgcn_readfirstlane(tid >> 6), lane = tid & 63, wr = wid >> 2, wc = wid & 3, fr = lane & 15, fq = lane >> 4;
    const int K = g.K, nt = K / BK;
    unsigned voffA[2], voffB[2];
#pragma unroll
    for (int i = 0; i < 2; ++i) { int R, C; stage_rc(tid * 16 + i * 8192, R, C); const int Rb = Epi::PERM ? ((R & ~31) + perm32(R & 31)) : R;
        voffA[i] = (unsigned)(R * K + C) * 2u; voffB[i] = (unsigned)(Rb * K + C) * 2u; }
    const size_t kstep = (size_t)(BK * 2);
    const size_t hstep = (size_t)HALF * K * 2;
    const size_t tstep = 2 * hstep;
    const unsigned ldsw = (unsigned)wid * 1024u;
    const int aoff = lds_byte(wr * 64 + fr, fq * 8), boff = lds_byte(wc * 32 + fr, fq * 8);
#define PG8_SA(b, h) (((b) * 2 + (h)) * HTB)
#define PG8_SB(b, h) ((4 + (b) * 2 + (h)) * HTB)
#define PG8_STAGE(bufoff, gbase, voff) do { _Pragma("unroll") for (int _i = 0; _i < 2; ++_i) \
        __builtin_amdgcn_global_load_lds((const unsigned*)((const char*)(gbase) + (voff)[_i]), (PG8_LAS unsigned*)(lds + (bufoff) + ldsw + _i * 8192), 16, 0, 0); } while (0)
#define PG8_LDA(dst, b, h) do { _Pragma("unroll") for (int m = 0; m < 4; ++m) _Pragma("unroll") for (int k = 0; k < 2; ++k) dst[m][k] = *(const PG8_LAS bf16x8*)(lds + PG8_SA(b, h) + aoff + m * 2048 + k * 1024); } while (0)
#define PG8_LDB(dst, b, h) do { _Pragma("unroll") for (int n = 0; n < 2; ++n) _Pragma("unroll") for (int k = 0; k < 2; ++k) dst[n][k] = *(const PG8_LAS bf16x8*)(lds + PG8_SB(b, h) + boff + n * 2048 + k * 1024); } while (0)
#define PG8_MMA(ai, bj, At, Bt) do { __builtin_amdgcn_s_setprio(1); _Pragma("unroll") for (int m = 0; m < 4; ++m) _Pragma("unroll") for (int n = 0; n < 2; ++n) _Pragma("unroll") for (int k = 0; k < 2; ++k) \
        acc[ai][bj][m][n] = __builtin_amdgcn_mfma_f32_16x16x32_bf16(Bt[n][k], At[m][k], acc[ai][bj][m][n], 0, 0, 0); __builtin_amdgcn_s_setprio(0); } while (0)
#define PG8_WAIT_V(n) asm volatile("s_waitcnt vmcnt(" #n ")" ::: "memory")
#define PG8_WAIT_L(n) asm volatile("s_waitcnt lgkmcnt(" #n ")" ::: "memory")
#define PG8_BAR __builtin_amdgcn_s_barrier()
#define PG8_SCHED __builtin_amdgcn_sched_barrier(0)
    Unit cur, nxt; int ui = 0;
    if (!S.next(0, cur)) return;
    f32x4 acc[2][2][4][2];
#pragma unroll
    for (int a = 0; a < 2; ++a)
#pragma unroll
        for (int b = 0; b < 2; ++b)
#pragma unroll
            for (int m = 0; m < 4; ++m)
#pragma unroll
                for (int n = 0; n < 2; ++n) acc[a][b][m][n] = (f32x4){0.f, 0.f, 0.f, 0.f};
    bf16x8 At[4][2], B0[2][2], B1[2][2];
    const char* cA = (const char*)g.A + (size_t)cur.pm * tstep; const char* cB = (const char*)g.Bt + (size_t)cur.pn * tstep;
    S.a_ready(cur);
    if constexpr (SP2) {
        PG8_STAGE(PG8_SB(0, 0), cB, voffB); PG8_STAGE(PG8_SB(0, 1), cB + hstep, voffB); PG8_STAGE(PG8_SA(0, 0), cA, voffA); PG8_STAGE(PG8_SA(0, 1), cA + hstep, voffA);
        if (wr == 1) PG8_BAR;
        PG8_WAIT_V(2); PG8_BAR;
        PG8_STAGE(PG8_SB(1, 0), cB + kstep, voffB); PG8_STAGE(PG8_SA(1, 0), cA + kstep, voffA); PG8_STAGE(PG8_SB(1, 1), cB + hstep + kstep, voffB);
        PG8_WAIT_V(6); PG8_BAR;
    } else {
        PG8_STAGE(PG8_SB(0, 0), cB, voffB); PG8_STAGE(PG8_SA(0, 0), cA, voffA); PG8_STAGE(PG8_SB(0, 1), cB + hstep, voffB); PG8_STAGE(PG8_SA(0, 1), cA + hstep, voffA);
        if (wr == 1) PG8_BAR;
        PG8_WAIT_V(4); PG8_BAR;
        PG8_STAGE(PG8_SB(1, 0), cB + kstep, voffB); PG8_STAGE(PG8_SA(1, 0), cA + kstep, voffA); PG8_STAGE(PG8_SB(1, 1), cB + hstep + kstep, voffB);
        PG8_WAIT_V(6); PG8_BAR;
    }
    for (;;) {
        const bool has_next = S.next(ui + 1, nxt);
        const char* nA = has_next ? (const char*)g.A + (size_t)nxt.pm * tstep : cA; const char* nB = has_next ? (const char*)g.Bt + (size_t)nxt.pn * tstep : cB;
        for (int t = 0; t < nt; t += 2) {
            const bool last = (t == nt - 2);
            const char* a1 = cA + (size_t)(t + 1) * kstep;
            const char* a2 = last ? nA : cA + (size_t)(t + 2) * kstep; const char* b2 = last ? nB : cB + (size_t)(t + 2) * kstep;
            const char* a3 = a2 + kstep; const char* b3 = b2 + kstep;
            if (last && has_next) S.a_ready(nxt);
            if constexpr (SP2) {
            PG8_LDB(B0, 0, 0); PG8_LDB(B1, 0, 1); PG8_SCHED; PG8_LDA(At, 0, 0); PG8_STAGE(PG8_SA(1, 1), a1 + hstep, voffA);
            PG8_WAIT_V(8); PG8_WAIT_L(0); PG8_BAR; PG8_MMA(0, 0, At, B0); PG8_MMA(0, 1, At, B1); PG8_BAR; PG8_SCHED;
            PG8_LDA(At, 0, 1); PG8_STAGE(PG8_SB(0, 0), b2, voffB); PG8_STAGE(PG8_SB(0, 1), b2 + hstep, voffB); PG8_STAGE(PG8_SA(0, 0), a2, voffA);
            PG8_WAIT_V(8); PG8_WAIT_L(0); PG8_BAR; PG8_MMA(1, 0, At, B0); PG8_MMA(1, 1, At, B1); PG8_BAR; PG8_SCHED;
            PG8_LDB(B0, 1, 0); PG8_LDB(B1, 1, 1); PG8_SCHED; PG8_LDA(At, 1, 0); PG8_STAGE(PG8_SA(0, 1), a2 + hstep, voffA);
            PG8_WAIT_V(8); PG8_WAIT_L(0); PG8_BAR; PG8_MMA(0, 0, At, B0); PG8_MMA(0, 1, At, B1); PG8_BAR; PG8_SCHED;
            PG8_LDA(At, 1, 1); PG8_STAGE(PG8_SB(1, 0), b3, voffB); PG8_STAGE(PG8_SB(1, 1), b3 + hstep, voffB); PG8_STAGE(PG8_SA(1, 0), a3, voffA);
            PG8_WAIT_V(8); PG8_WAIT_L(0); PG8_BAR; PG8_MMA(1, 0, At, B0); PG8_MMA(1, 1, At, B1); PG8_BAR; PG8_SCHED;
            } else {
            PG8_LDB(B0, 0, 0); PG8_SCHED; PG8_LDA(At, 0, 0); PG8_STAGE(PG8_SA(1, 1), a1 + hstep, voffA);
            PG8_WAIT_L(8); PG8_BAR; PG8_WAIT_L(0); PG8_MMA(0, 0, At, B0); PG8_BAR; PG8_SCHED;
            PG8_LDB(B1, 0, 1); PG8_STAGE(PG8_SB(0, 0), b2, voffB);
            PG8_BAR; PG8_WAIT_L(0); PG8_MMA(0, 1, At, B1); PG8_BAR;
            PG8_LDA(At, 0, 1); PG8_STAGE(PG8_SA(0, 0), a2, voffA);
            PG8_BAR; PG8_WAIT_L(0); PG8_MMA(1, 0, At, B0); PG8_BAR; PG8_SCHED;
            PG8_STAGE(PG8_SB(0, 1), b2 + hstep, voffB);
            PG8_WAIT_V(6); PG8_BAR; PG8_MMA(1, 1, At, B1); PG8_BAR;
            PG8_LDB(B0, 1, 0); PG8_SCHED; PG8_LDA(At, 1, 0); PG8_STAGE(PG8_SA(0, 1), a2 + hstep, voffA);
            PG8_WAIT_L(8); PG8_BAR; PG8_WAIT_L(0); PG8_MMA(0, 0, At, B0); PG8_BAR; PG8_SCHED;
            PG8_LDB(B1, 1, 1); PG8_STAGE(PG8_SB(1, 0), b3, voffB);
            PG8_BAR; PG8_WAIT_L(0); PG8_MMA(0, 1, At, B1); PG8_BAR;
            PG8_LDA(At, 1, 1); PG8_STAGE(PG8_SA(1, 0), a3, voffA);
            PG8_BAR; PG8_WAIT_L(0); PG8_MMA(1, 0, At, B0); PG8_BAR; PG8_SCHED;
            PG8_STAGE(PG8_SB(1, 1), b3 + hstep, voffB);
            PG8_WAIT_V(6); PG8_BAR; PG8_MMA(1, 1, At, B1); PG8_BAR;
            }
        }
        if constexpr (ALIGN_EPI) { if (wr == 0) PG8_BAR; }
        if constexpr (!Epi::AFTER_DRAIN) { E(acc, cur, wr, wc, fr, fq); S.done(cur); }
        if (!has_next) break;
#pragma unroll
        for (int a = 0; a < 2; ++a)
#pragma unroll
            for (int b = 0; b < 2; ++b)
#pragma unroll
                for (int m = 0; m < 4; ++m)
#pragma unroll
                    for (int n = 0; n < 2; ++n) acc[a][b][m][n] = (f32x4){0.f, 0.f, 0.f, 0.f};
        cur = nxt; cA = nA; cB = nB; ++ui;
        if constexpr (ALIGN_EPI) { if (wr == 1) PG8_BAR; }
    }
    PG8_WAIT_V(0);
    if constexpr (!ALIGN_EPI) { if (wr == 0) PG8_BAR; }
    PG8_BAR;
    if constexpr (Epi::AFTER_DRAIN) { E.fused(acc, cur, wr, wc, fr, fq, lds, wid, lane); S.done(cur); }
#undef PG8_SA
#undef PG8_SB
#undef PG8_STAGE
#undef PG8_LDA
#undef PG8_LDB
#undef PG8_MMA
#undef PG8_WAIT_V
#undef PG8_WAIT_L
#undef PG8_BAR
#undef PG8_SCHED
}
}

#define LAS __attribute__((address_space(3)))
using pg8::bf16_t; using pg8::bf16x8; using pg8::f32x4; using pg8::u32x4; using pg8::u32x2; using pg8::cvt_pk_bf16;
typedef short s16x4 __attribute__((ext_vector_type(4)));

#define LDS_WAIT() asm volatile("s_waitcnt lgkmcnt(0)" ::: "memory")
__device__ __forceinline__ float bf2f(unsigned short b) { return __uint_as_float(((unsigned)b) << 16); }
__device__ __forceinline__ unsigned short f2bf1(float f) { return (unsigned short)(cvt_pk_bf16(f, 0.f) & 0xffffu); }
__device__ __forceinline__ float wave_sum(float v) {
#pragma unroll
    for (int o = 1; o < 64; o <<= 1) v += __shfl_xor(v, o);
    return v;
}
__device__ __forceinline__ f32x4 mfma16(bf16x8 a, bf16x8 b, f32x4 c) { return __builtin_amdgcn_mfma_f32_16x16x32_bf16(a, b, c, 0, 0, 0); }
__device__ __forceinline__ s16x4 tr16(const LAS unsigned char* p) { return __builtin_amdgcn_ds_read_tr16_b64_v4i16((LAS s16x4*)p); }

__device__ __forceinline__ int t5_bucket(int d) {
    if (d < 16) return d;
    return 16 + (d >= 21) + (d >= 27) + (d >= 35) + (d >= 46) + (d >= 59) + (d >= 77) + (d >= 99) + (d >= 128) + (d >= 166) + (d >= 216) + (d >= 280) + (d >= 363) + (d >= 470) + (d >= 609) + (d >= 790);
}
__device__ __forceinline__ int proj_map(int n) { return n < 2560 ? n : (n < 2608 ? n + 1280 : (n < NPROJ ? n - 48 : n)); }

__device__ __forceinline__ void tr_item(const float* __restrict__ W, int K, int Nsrc, int nblk, bf16_t* WT, int mode, int roff, LAS unsigned char* scr, int item, int lane) {
    const int kg = item / nblk, nb = item - kg * nblk, k0 = 64 * kg, n0 = 128 * nb;
    const int nq = lane & 31, kh = lane >> 5, n = n0 + 4 * nq; const bool ok = n < Nsrc;
    const float* wp = W + (size_t)(k0 + 32 * kh) * Nsrc + n;
#pragma unroll 2
    for (int b = 0; b < 4; ++b) {
        f32x4 v[8];
#pragma unroll
        for (int j = 0; j < 8; ++j) v[j] = ok ? *(const f32x4*)(wp + (size_t)(8 * b + j) * Nsrc) : (f32x4){0.f, 0.f, 0.f, 0.f};
#pragma unroll
        for (int c = 0; c < 4; ++c) { u32x4 o; o.x = cvt_pk_bf16(v[0][c], v[1][c]); o.y = cvt_pk_bf16(v[2][c], v[3][c]); o.z = cvt_pk_bf16(v[4][c], v[5][c]); o.w = cvt_pk_bf16(v[6][c], v[7][c]);
            *(LAS u32x4*)(scr + (4 * nq + c) * 128 + (((4 * kh + b) ^ (nq & 7)) << 4)) = o; }
    }
    LDS_WAIT(); asm volatile("" ::: "memory");
#pragma unroll 4
    for (int s = 0; s < 16; ++s) { const int row = 8 * s + (lane >> 3), ch = lane & 7, dn = n0 + row;
        if (dn < Nsrc || mode == 1) { const u32x4 o = *(const LAS u32x4*)(scr + row * 128 + ((ch ^ ((row >> 2) & 7)) << 4));
            const int dr = mode == 1 ? proj_map(dn) : (mode == 2 ? ((dn >> 7) << 8) + (roff << 7) + (dn & 127) : dn);
            *(u32x4*)(WT + (size_t)dr * K + k0 + 8 * ch) = o; } }
    LDS_WAIT(); asm volatile("" ::: "memory");
}

constexpr int PREP_NITEMS = 32 * 32 + 32 * 16 + 2 * (32 * 44) + 88 * 16 + 2 * (32 * 2) + 2 * (4 * 1) + 256;
constexpr int PREP_EARLY = 2432;
__device__ __forceinline__ void prep_phase(const __attribute__((address_space(4))) Params* Pq, int L, LAS unsigned char* lds, int gw, int ngw, int tid, int lane, int wave, int it_lo = 0, int it_hi = PREP_NITEMS, bool tail_part = true) {
    const __attribute__((address_space(4))) Params& P = *Pq;
    unsigned char* ws = P.ws;
    constexpr int I_IN = 32 * 32, I_OUT = 32 * 16, I_G = 32 * 44, I_DN = 88 * 16, I_C1 = 32 * 2, I_C2 = 4 * 1, I_CB = 256;
    LAS unsigned char* scr = lds + wave * 16384;
    constexpr int NITEMS = I_IN + I_OUT + 2 * I_G + I_DN + 2 * I_C1 + 2 * I_C2 + I_CB;
    static_assert(NITEMS == PREP_NITEMS && PREP_EARLY <= 2 * I_G, "prep item table");
    for (int it = it_lo + gw; it < it_hi; it += ngw) {
        int r = it; const float* W; bf16_t* WT; int K, Ns, nblk, mode = 0, roff = 0;
        if (r < 2 * I_G) { const int up = r >= I_G; r -= up * I_G; W = P.in[14 + up] + (size_t)L * DM * DFF; WT = (bf16_t*)(ws + ((L & 1) ? WS_WGU_B : WS_WGU)); K = DM; Ns = DFF; nblk = 44; mode = 2; roff = up; }
        else if ((r -= 2 * I_G) < I_DN) { W = P.in[16] + (size_t)L * DFF * DM; WT = (bf16_t*)(ws + ((L & 1) ? WS_WDN_B : WS_WDN)); K = DFF; Ns = DM; nblk = 16; }
        else if ((r -= I_DN) < I_IN) { W = P.in[4] + (size_t)L * DM * NPROJ; WT = (bf16_t*)(ws + WS_WIN); K = DM; Ns = NPROJ; nblk = 32; mode = 1; }
        else if ((r -= I_IN) < I_OUT) { W = P.in[13] + (size_t)L * DM * DM; WT = (bf16_t*)(ws + WS_WOUT); K = DM; Ns = DM; nblk = 16; }
        else if ((r -= I_OUT) < 2 * I_C1) { const int v = r >= I_C1; r -= v * I_C1; W = P.in[8 + 2 * v] + (size_t)L * 2048 * 256; WT = (bf16_t*)(ws + (v ? WS_C1V : WS_C1K)); K = 2048; Ns = 256; nblk = 2; }
        else if ((r -= 2 * I_C1) < 2 * I_C2) { const int v = r >= I_C2; r -= v * I_C2; W = P.in[9 + 2 * v] + (size_t)L * 256 * 64; WT = (bf16_t*)(ws + (v ? WS_C2V : WS_C2K)); K = 256; Ns = 64; nblk = 1; }
        else {
            r -= 2 * I_C2;
            const int mat = r >> 7, kch = (r >> 2) & 31, n = 64 * (r & 3) + lane;
            const float* pos = P.in[6 + mat] + (size_t)L * 2048 + 64 * kch; const float* w1 = P.in[8 + 2 * mat] + (size_t)L * 2048 * 256 + (size_t)(64 * kch) * 256 + n;
            float s = 0.f;
#pragma unroll 16
            for (int k = 0; k < 64; ++k) s += pos[k] * w1[(size_t)k * 256];
            ((float*)(ws + WS_CBP))[(mat * 32 + kch) * 256 + n] = s;
            continue;
        }
        tr_item(W, K, Ns, nblk, WT, mode, roff, scr, r, lane);
    }
    if (!tail_part) return;
    const int gt = gw * 64 + lane;
    if (gt < NP) { const int d = gt; float v = 0.f;
        if (d < NPROJ) { const int src = d < 2560 ? d : (d < 3840 ? d + 48 : d - 1280); v = P.in[5][(size_t)L * NPROJ + src]; }
        ((float*)(ws + WS_BIASP))[d] = v; }
    if (L == 0) {
        for (int e = gt; e < 32 * 1024; e += ngw * 64) { const int h = e >> 10, d = 1023 - (e & 1023); ((float*)(ws + WS_BT))[e] = P.in[1][t5_bucket(d) * 32 + h] * LOG2E; }
    }
}

__device__ __forceinline__ void rows_bf16_ssq(const float* x, const float* gwt, bf16_t* xb, float* ssq, int gw, int ngw, int lane) {
    for (int m = gw; m < MTOK; m += ngw) {
        const f32x4* xr = (const f32x4*)(x + (size_t)m * DM) + lane; u32x2* o = (u32x2*)(xb + (size_t)m * DM) + lane; float s = 0.f;
#pragma unroll
        for (int j = 0; j < 8; ++j) { const f32x4 v = xr[64 * j]; s += (v[0] * v[0] + v[1] * v[1]) + (v[2] * v[2] + v[3] * v[3]); const f32x4 h = v * ((const f32x4*)gwt + lane)[64 * j];
            u32x2 w; w.x = cvt_pk_bf16(h[0], h[1]); w.y = cvt_pk_bf16(h[2], h[3]); o[64 * j] = w; }
        s = wave_sum(s);
        if (lane < 32) ssq[(size_t)m * 32 + lane] = lane == 0 ? s : 0.f;
    }
}
__device__ __forceinline__ void norm_rows_f32(const float* __restrict__ x, const float* __restrict__ gwt, float* __restrict__ out, int gw, int ngw, int lane) {
    for (int m = gw; m < MTOK; m += 2 * ngw) {
        const int m1 = m + ngw; const bool two = m1 < MTOK;
        const f32x4* xr0 = (const f32x4*)(x + (size_t)m * DM) + lane; const f32x4* xr1 = (const f32x4*)(x + (size_t)(two ? m1 : m) * DM) + lane;
        f32x4 v0[8], v1[8]; float s0 = 0.f, s1 = 0.f;
#pragma unroll
        for (int j = 0; j < 8; ++j) { v0[j] = xr0[64 * j]; v1[j] = xr1[64 * j]; }
#pragma unroll
        for (int j = 0; j < 8; ++j) { s0 += (v0[j][0] * v0[j][0] + v0[j][1] * v0[j][1]) + (v0[j][2] * v0[j][2] + v0[j][3] * v0[j][3]); s1 += (v1[j][0] * v1[j][0] + v1[j][1] * v1[j][1]) + (v1[j][2] * v1[j][2] + v1[j][3] * v1[j][3]); }
        const float r0 = 1.0f / sqrtf(wave_sum(s0) * (1.0f / DM) + 1e-5f), r1 = 1.0f / sqrtf(wave_sum(s1) * (1.0f / DM) + 1e-5f);
        const f32x4* gr = (const f32x4*)gwt + lane; f32x4* o0 = (f32x4*)(out + (size_t)m * DM) + lane; f32x4* o1 = (f32x4*)(out + (size_t)m1 * DM) + lane;
#pragma unroll
        for (int j = 0; j < 8; ++j) { const f32x4 gg = gr[64 * j]; o0[64 * j] = v0[j] * r0 * gg; if (two) o1[64 * j] = v1[j] * r1 * gg; }
    }
}

constexpr int TILE_U = 8192;
constexpr int REP_SEL = 1;
__device__ __forceinline__ void stage_tile(LAS unsigned char* dst, const bf16_t* src, size_t rstride, int tid) {
    const int r = tid >> 3, ch = tid & 7;
    const u32x4 v = *(const u32x4*)(src + (size_t)r * rstride + ch * 8);
    *(LAS u32x4*)(dst + r * 128 + ((ch ^ (r & 7)) << 4)) = v;
}
__device__ __forceinline__ void dma_tile(LAS unsigned char* dstK, const bf16_t* ksrc, const bf16_t* vsrc, size_t rstride, int lane, int wave) {
    const int rl = lane >> 3, c = (lane & 7) ^ rl;
    const size_t off = (size_t)(8 * wave + rl) * rstride + c * 8;
    __builtin_amdgcn_global_load_lds((const unsigned*)(ksrc + off), (LAS unsigned*)(dstK + wave * 1024), 16, 0, 0);
    __builtin_amdgcn_global_load_lds((const unsigned*)(vsrc + off), (LAS unsigned*)(dstK + TILE_U + wave * 1024), 16, 0, 0);
}
#define RING_WAIT_BARRIER(rem) do { if ((rem) >= 2) asm volatile("s_waitcnt vmcnt(4)" ::: "memory"); else if ((rem) == 1) asm volatile("s_waitcnt vmcnt(2)" ::: "memory"); \
    else asm volatile("s_waitcnt vmcnt(0)" ::: "memory"); asm volatile("s_waitcnt lgkmcnt(0)" ::: "memory"); __builtin_amdgcn_s_barrier(); asm volatile("" ::: "memory"); } while (0)
constexpr int RING_PD = 3, RING_NB = 4;
#define RING_PAIR_BARRIER() do { asm volatile("s_waitcnt vmcnt(0)" ::: "memory"); asm volatile("s_waitcnt lgkmcnt(0)" ::: "memory"); __builtin_amdgcn_s_barrier(); asm volatile("" ::: "memory"); } while (0)

template <int MODE, int PATH, int TSH = 0>
__device__ __forceinline__ void flash_tile(const LAS unsigned char* Kt, const LAS unsigned char* Vt, const LAS float* biasT, const bf16x8 (&qf)[2][2],
                                           f32x4 (&o)[2][4], float (&m)[2], float (&l)[2], int tq0, int kp0, int W,
                                           unsigned long long mk0, unsigned long long mk1, int jblk, int dm1, int lane) {
    const int i16 = lane & 15, g = lane >> 4;
    const int ksw0 = (g ^ (i16 & 7)) << 4, ksw1 = ((4 + g) ^ (i16 & 7)) << 4;
    bool bits[2] = {true, true};
    if (MODE == 1) { bits[0] = ((mk0 >> jblk) & 1ull) != 0ull; bits[1] = ((mk1 >> jblk) & 1ull) != 0ull;
        if (__ballot(bits[0] || bits[1]) == 0ull) return; }
    bf16x8 pf[2][2];
#pragma unroll
    for (int cb = 0; cb < 2; ++cb) {
        const bool bit = bits[cb];
        if (MODE == 1 && __ballot(bit) == 0ull) { pf[cb][0] = (bf16x8){0, 0, 0, 0, 0, 0, 0, 0}; pf[cb][1] = (bf16x8){0, 0, 0, 0, 0, 0, 0, 0}; continue; }
        f32x4 s[4];
        {
            bf16x8 ka[4][2];
#pragma unroll
            for (int kb = 0; kb < 4; ++kb) { const LAS unsigned char* kr = Kt + (16 * kb + i16) * 128; ka[kb][0] = *(const LAS bf16x8*)(kr + ksw0); ka[kb][1] = *(const LAS bf16x8*)(kr + ksw1); }
#pragma unroll
            for (int kb = 0; kb < 4; ++kb) { f32x4 z = {0.f, 0.f, 0.f, 0.f}; z = mfma16(ka[kb][0], qf[cb][0], z); z = mfma16(ka[kb][1], qf[cb][1], z); s[kb] = z; }
        }
        const int tq = tq0 + ((16 * cb + i16) >> TSH);
        float tmax = -1e30f, sub;
        if (PATH == 0) {
#pragma unroll
            for (int kb = 0; kb < 4; ++kb)
#pragma unroll
                for (int r = 0; r < 4; ++r) {
                    const int kk = kp0 + 16 * kb + 4 * g + r;
                    int dist; bool valid;
                    if (MODE == 2) { dist = tq - (16 * kk + 31); valid = dist >= 0 && kk < 255; }
                    else if (MODE == 0) { dist = tq - kk; valid = dist >= 0 && dist < W; }
                    else { dist = tq - kk; valid = dist >= 0 && bit; }
                    const int di = min(max(dist, 0), dm1);
                    float t = s[kb][r] * SCL2 + biasT[dm1 - di];
                    t = valid ? t : -1e30f;
                    s[kb][r] = t; tmax = fmaxf(tmax, t);
                }
        } else {
            if (PATH == 1) { constexpr int KS = MODE == 2 ? 16 : 1;
                const LAS float* pb = biasT + (MODE == 2 ? dm1 - tq + 31 + 16 * kp0 + 64 * g : dm1 - tq + kp0 + 4 * g);
#pragma unroll
                for (int kb = 0; kb < 4; ++kb) { const f32x4 b4 = {pb[KS * 16 * kb], pb[KS * (16 * kb + 1)], pb[KS * (16 * kb + 2)], pb[KS * (16 * kb + 3)]}; s[kb] = s[kb] * SCL2 + b4; } }
            else { const float bc = biasT[dm1 - 1023];
#pragma unroll
                for (int kb = 0; kb < 4; ++kb) s[kb] = s[kb] * SCL2 + bc; }
#pragma unroll
            for (int kb = 0; kb < 4; ++kb) tmax = fmaxf(fmaxf(tmax, fmaxf(s[kb][0], s[kb][1])), fmaxf(s[kb][2], s[kb][3]));
        }
        tmax = fmaxf(tmax, __shfl_xor(tmax, 16)); tmax = fmaxf(tmax, __shfl_xor(tmax, 32));
        if (MODE == 1 && PATH != 0) tmax = bit ? tmax : -1e30f;
        const float mn = fmaxf(m[cb], tmax), alpha = __builtin_amdgcn_exp2f(m[cb] - mn);
        m[cb] = mn; float ls = l[cb] * alpha;
        sub = (MODE == 1 && PATH != 0 && !bit) ? 1e30f : mn;
#pragma unroll
        for (int c = 0; c < 4; ++c) o[cb][c] = o[cb][c] * alpha;
#pragma unroll
        for (int kb = 0; kb < 4; ++kb)
#pragma unroll
            for (int r = 0; r < 4; ++r) { const float t = s[kb][r];
                const float pv = PATH == 0 ? (t > -1e29f ? __builtin_amdgcn_exp2f(t - mn) : 0.f) : __builtin_amdgcn_exp2f(t - sub);
                s[kb][r] = pv; ls += pv; }
        l[cb] = ls;
#pragma unroll
        for (int ks = 0; ks < 2; ++ks) { u32x4 w; w.x = cvt_pk_bf16(s[2 * ks][0], s[2 * ks][1]); w.y = cvt_pk_bf16(s[2 * ks][2], s[2 * ks][3]);
            w.z = cvt_pk_bf16(s[2 * ks + 1][0], s[2 * ks + 1][1]); w.w = cvt_pk_bf16(s[2 * ks + 1][2], s[2 * ks + 1][3]); pf[cb][ks] = __builtin_bit_cast(bf16x8, w); }
        asm volatile("" ::: "memory");
    }
    const int vr = 4 * g + (i16 >> 2), p4 = lane & 3;
    const LAS unsigned char* vb = Vt + vr * 128 + 8 * (p4 & 1);
#pragma unroll
    for (int ks = 0; ks < 2; ++ks) {
        bf16x8 vf[4];
#pragma unroll
        for (int c = 0; c < 4; ++c) {
            const int vsw = ((2 * c + (p4 >> 1)) ^ (vr & 7)) << 4;
            const s16x4 v0 = tr16(vb + (32 * ks) * 128 + vsw), v1 = tr16(vb + (32 * ks + 16) * 128 + vsw);
            vf[c] = (bf16x8){v0[0], v0[1], v0[2], v0[3], v1[0], v1[1], v1[2], v1[3]};
        }
#pragma unroll
        for (int c = 0; c < 4; ++c)
#pragma unroll
            for (int cb = 0; cb < 2; ++cb) o[cb][c] = mfma16(vf[c], pf[cb][ks], o[cb][c]);
    }
}

#define FLASH_INIT(o, m, l) do { _Pragma("unroll") for (int cb_ = 0; cb_ < 2; ++cb_) { m[cb_] = -1e30f; l[cb_] = 0.f; _Pragma("unroll") for (int c_ = 0; c_ < 4; ++c_) o[cb_][c_] = (f32x4){0.f, 0.f, 0.f, 0.f}; } } while (0)
constexpr int F2R_BYTES = 16 * 68 * 4;
__device__ __forceinline__ void frag_to_rows(const f32x4 (&o)[4], f32x4 (&t)[4], LAS float* scr, int i16, int g) {
#pragma unroll
    for (int c = 0; c < 4; ++c) *(LAS f32x4*)(scr + i16 * 68 + 16 * c + 4 * g) = o[c];
    LDS_WAIT(); asm volatile("" ::: "memory");
#pragma unroll
    for (int q = 0; q < 4; ++q) t[q] = *(const LAS f32x4*)(scr + i16 * 68 + 16 * g + 4 * q);
    LDS_WAIT(); asm volatile("" ::: "memory");
}
__device__ __forceinline__ void store_row16_bf16(bf16_t* p, const f32x4 (&t)[4]) {
    u32x4 a, b; a.x = cvt_pk_bf16(t[0][0], t[0][1]); a.y = cvt_pk_bf16(t[0][2], t[0][3]); a.z = cvt_pk_bf16(t[1][0], t[1][1]); a.w = cvt_pk_bf16(t[1][2], t[1][3]);
    b.x = cvt_pk_bf16(t[2][0], t[2][1]); b.y = cvt_pk_bf16(t[2][2], t[2][3]); b.z = cvt_pk_bf16(t[3][0], t[3][1]); b.w = cvt_pk_bf16(t[3][2], t[3][3]);
    *(u32x4*)p = a; *(u32x4*)(p + 8) = b;
}
__device__ __forceinline__ float quad_sum(float v) { v += __shfl_xor(v, 16); v += __shfl_xor(v, 32); return v; }

__device__ __forceinline__ void swa_unit(int u, const bf16_t* PROJ, const float* BT, const float* sinks, bf16_t* AO, LAS unsigned char* lds, int tid, int lane, int wave) {
    const int b = u >> 8, kvh = (u >> 7) & 1, t0 = (u & 127) * 32, head = kvh * 8 + wave, i16 = lane & 15, g = lane >> 4;
    LAS float* lb = (LAS float*)lds; LAS unsigned char* KV = lds + 32768;
    const bf16_t* prow = PROJ + (size_t)(b * SEQ) * NP;
    const bf16_t* kbase = prow + C_KB + kvh * 64; const bf16_t* vbase = prow + C_VB + kvh * 64;
    const int kt0 = max(t0 - 127, 0) >> 6, kt1 = (t0 + 31) >> 6;
    bf16x8 qf[2][2];
#pragma unroll
    for (int cb = 0; cb < 2; ++cb)
#pragma unroll
        for (int s = 0; s < 2; ++s) qf[cb][s] = *(const bf16x8*)(prow + (size_t)(t0 + 16 * cb + i16) * NP + C_QB + head * 64 + 32 * s + 8 * g);
    __syncthreads();
    if (tid < 256) ((LAS f32x4*)lb)[tid] = *(const f32x4*)(BT + (16 + kvh * 8 + (tid >> 5)) * 1024 + 896 + 4 * (tid & 31));
    asm volatile("s_waitcnt vmcnt(0)" ::: "memory");
    const int nt = kt1 - kt0 + 1;
    for (int p = 0; p < 2 && p < nt; ++p) dma_tile(KV + p * 2 * TILE_U, kbase + (size_t)((kt0 + p) * 64) * NP, vbase + (size_t)((kt0 + p) * 64) * NP, NP, lane, wave);
    f32x4 o[2][4]; float m[2], l[2]; FLASH_INIT(o, m, l);
    for (int i = 0; i < nt; i += 2) {
        RING_PAIR_BARRIER();
        for (int h = 2; h < 4; ++h) if (i + h < nt) dma_tile(KV + ((i + h) & 3) * 2 * TILE_U, kbase + (size_t)((kt0 + i + h) * 64) * NP, vbase + (size_t)((kt0 + i + h) * 64) * NP, NP, lane, wave);
#pragma unroll 1
        for (int h = 0; h < 2; ++h) { if (i + h >= nt) break;
            const LAS unsigned char* Kt = KV + ((i + h) & 3) * 2 * TILE_U; const int kp0 = (kt0 + i + h) * 64;
            if (kp0 + 63 <= t0 && t0 + 31 - kp0 <= 127) flash_tile<0, 1>(Kt, Kt + TILE_U, lb + wave * 128, qf, o, m, l, t0, kp0, 128, 0ull, 0ull, 0, 127, lane);
            else flash_tile<0, 0>(Kt, Kt + TILE_U, lb + wave * 128, qf, o, m, l, t0, kp0, 128, 0ull, 0ull, 0, 127, lane); }
    }
    const float sk = sinks[head] * LOG2E;
    __syncthreads();
    LAS float* scr = (LAS float*)(KV + wave * F2R_BYTES);
#pragma unroll
    for (int cb = 0; cb < 2; ++cb) {
        const float lt = quad_sum(l[cb]); const float inv = 1.0f / (lt + __builtin_amdgcn_exp2f(sk - m[cb]));
        f32x4 v[4], t[4];
#pragma unroll
        for (int c = 0; c < 4; ++c) v[c] = o[cb][c] * inv;
        frag_to_rows(v, t, scr, i16, g);
        store_row16_bf16(AO + (size_t)(b * SEQ + t0 + 16 * cb + i16) * DM + 1024 + head * 64 + 16 * g, t);
    }
}

__device__ __forceinline__ void nsaw_unit(int u, const bf16_t* PROJ, const float* BT, bf16_t* OW, LAS unsigned char* lds, int tid, int lane, int wave) {
    const int b = u >> 8, kvh = (u >> 6) & 3, t0 = (u & 63) * 64, hl = wave & 3, head = kvh * 4 + hl, tq0 = t0 + 32 * (wave >> 2), i16 = lane & 15, g = lane >> 4;
    LAS float* lb = (LAS float*)lds; LAS unsigned char* KV = lds + 32768;
    const bf16_t* prow = PROJ + (size_t)(b * SEQ) * NP;
    const bf16_t* kbase = prow + C_KW + kvh * 64; const bf16_t* vbase = prow + C_VW + kvh * 64;
    const int kt0 = max(t0 - 511, 0) >> 6, kt1 = (t0 + 63) >> 6;
    bf16x8 qf[2][2];
#pragma unroll
    for (int cb = 0; cb < 2; ++cb)
#pragma unroll
        for (int s = 0; s < 2; ++s) qf[cb][s] = *(const bf16x8*)(prow + (size_t)(tq0 + 16 * cb + i16) * NP + C_QA + head * 64 + 32 * s + 8 * g);
    __syncthreads();
    { const f32x4* bsrc = (const f32x4*)(BT + kvh * 4 * 1024); ((LAS f32x4*)lb)[tid] = bsrc[tid]; ((LAS f32x4*)lb)[tid + 512] = bsrc[tid + 512]; }
    asm volatile("s_waitcnt vmcnt(0)" ::: "memory");
    const int nt = kt1 - kt0 + 1;
    for (int p = 0; p < 2 && p < nt; ++p) dma_tile(KV + p * 2 * TILE_U, kbase + (size_t)((kt0 + p) * 64) * NP, vbase + (size_t)((kt0 + p) * 64) * NP, NP, lane, wave);
    f32x4 o[2][4]; float m[2], l[2]; FLASH_INIT(o, m, l);
    for (int i = 0; i < nt; i += 2) {
        RING_PAIR_BARRIER();
        for (int h = 2; h < 4; ++h) if (i + h < nt) dma_tile(KV + ((i + h) & 3) * 2 * TILE_U, kbase + (size_t)((kt0 + i + h) * 64) * NP, vbase + (size_t)((kt0 + i + h) * 64) * NP, NP, lane, wave);
#pragma unroll 1
        for (int h = 0; h < 2; ++h) { if (i + h >= nt) break;
            const LAS unsigned char* Kt = KV + ((i + h) & 3) * 2 * TILE_U; const int kp0 = (kt0 + i + h) * 64;
            if (kp0 + 63 <= tq0 && tq0 + 31 - kp0 <= 511) flash_tile<0, 1>(Kt, Kt + TILE_U, lb + hl * 1024, qf, o, m, l, tq0, kp0, 512, 0ull, 0ull, 0, 1023, lane);
            else flash_tile<0, 0>(Kt, Kt + TILE_U, lb + hl * 1024, qf, o, m, l, tq0, kp0, 512, 0ull, 0ull, 0, 1023, lane); }
    }
    __syncthreads();
    LAS float* scr = (LAS float*)(KV + wave * F2R_BYTES);
#pragma unroll
    for (int cb = 0; cb < 2; ++cb) {
        const float lt = quad_sum(l[cb]); const float inv = lt > 0.f ? 1.0f / lt : 0.f;
        f32x4 v[4], t[4];
#pragma unroll
        for (int c = 0; c < 4; ++c) v[c] = o[cb][c] * inv;
        frag_to_rows(v, t, scr, i16, g);
        store_row16_bf16(OW + (size_t)(b * SEQ + tq0 + 16 * cb + i16) * 1024 + head * 64 + 16 * g, t);
    }
}

__device__ __forceinline__ float gelu_tanh(float x) {
    const float y = 0.7978845608028654f * (x + 0.044715f * x * x * x);
    const float e = __expf(2.0f * y);
    const float th = 1.0f - 2.0f / (e + 1.0f);
    return 0.5f * x * (1.0f + th);
}

__device__ __forceinline__ void compress_unit(int u, const bf16_t* PROJ, int ccol, const bf16_t* W1T, const bf16_t* W2T, const float* cbp, bf16_t* OUT,
                                              LAS unsigned char* lds, int tid, int lane, int wave) {
    const int i16 = lane & 15, g = lane >> 4, bh = u >> 4, ti = u & 15, tbase = 256 * ti;
    const bf16_t* src = PROJ + (size_t)((bh >> 2) * SEQ) * NP + ccol + (bh & 3) * 64;
    LAS unsigned char* slab = lds; LAS bf16_t* H = (LAS bf16_t*)(lds + 36864);
    __syncthreads();
    for (int q = tid; q < 272 * 8; q += 512) { const int r = q >> 3, ch = q & 7, tok = min(tbase + r, SEQ - 1);
        *(LAS u32x4*)(slab + r * 128 + ((ch ^ ((r >> 4) & 7)) << 4)) = *(const u32x4*)(src + (size_t)tok * NP + ch * 8); }
    const bf16_t* b0 = W1T + (size_t)(32 * wave + i16) * 2048 + 8 * g; const bf16_t* b1 = b0 + 16 * 2048;
    f32x4 acc0 = {0.f, 0.f, 0.f, 0.f}, acc1 = {0.f, 0.f, 0.f, 0.f};
    __syncthreads();
#pragma unroll 8
    for (int kk = 0; kk < 64; ++kk) {
        const int r = 16 * i16 + (kk >> 1), chunk = 4 * (kk & 1) + g;
        const bf16x8 a = *(const LAS bf16x8*)(slab + r * 128 + ((chunk ^ ((r >> 4) & 7)) << 4));
        const bf16x8 w0 = *(const bf16x8*)(b0 + 32 * kk), w1 = *(const bf16x8*)(b1 + 32 * kk);
        acc0 = mfma16(a, w0, acc0); acc1 = mfma16(a, w1, acc1);
    }
#pragma unroll
    for (int nb = 0; nb < 2; ++nb) { const int n = 32 * wave + 16 * nb + i16; float cbv = 0.f;
#pragma unroll
        for (int q = 0; q < 32; ++q) cbv += cbp[q * 256 + n];
#pragma unroll
        for (int r = 0; r < 4; ++r) { const float x = (nb ? acc1[r] : acc0[r]) + cbv; H[(4 * g + r) * 264 + n] = f2bf1(gelu_tanh(x)); } }
    __syncthreads();
    if (wave < 4) {
        f32x4 acc = {0.f, 0.f, 0.f, 0.f};
#pragma unroll
        for (int ks = 0; ks < 8; ++ks) { const bf16x8 a = *(const LAS bf16x8*)(H + i16 * 264 + 32 * ks + 8 * g); const bf16x8 w = *(const bf16x8*)(W2T + (size_t)(16 * wave + i16) * 256 + 32 * ks + 8 * g); acc = mfma16(a, w, acc); }
#pragma unroll
        for (int r = 0; r < 4; ++r) { const int c2 = 16 * ti + 4 * g + r; OUT[(size_t)(bh * 256 + c2) * 64 + 16 * wave + i16] = c2 < 255 ? f2bf1(acc[r]) : (unsigned short)0; }
    }
}

__device__ __forceinline__ void nsa_unit(int u, const bf16_t* PROJ, const float* BT, const bf16_t* KC, const bf16_t* VC, const bf16_t* OW, float* OCB, bf16_t* AO,
                                         LAS unsigned char* lds, int tid, int lane, int wave) {
    const int b = u >> 8, kvh = (u >> 6) & 3, qt = u & 63, t0 = qt * 64;
    const int i16 = lane & 15, g = lane >> 4, hl = i16 & 3, head = kvh * 4 + hl, tq0 = t0 + 8 * wave, tl = i16 >> 2;
    LAS float* lb = (LAS float*)lds;
    LAS unsigned char* KCt = lds + 16384;
    LAS unsigned char* VCt = KCt + 4 * TILE_U;
    LAS float* IMP = (LAS float*)VCt;
    LAS unsigned long long* MASK = (LAS unsigned long long*)(VCt + 65536);
    const LAS float* lbh = lb + hl * 1024;
    __syncthreads();
    { const f32x4* bsrc = (const f32x4*)(BT + kvh * 4 * 1024); ((LAS f32x4*)lb)[tid] = bsrc[tid]; ((LAS f32x4*)lb)[tid + 512] = bsrc[tid + 512]; }
    const int cmax = min((t0 + 32) >> 4, 254), nct = (cmax >> 6) + 1;
    const bf16_t* kcb = KC + (size_t)((b * 4 + kvh) * 256) * 64; const bf16_t* vcb = VC + (size_t)((b * 4 + kvh) * 256) * 64;
    { const int rl = lane >> 3, cch = (lane & 7) ^ rl; const size_t goff = (size_t)(8 * wave + rl) * 64 + cch * 8;
      for (int kt = 0; kt < nct; ++kt) {
        __builtin_amdgcn_global_load_lds((const unsigned*)(kcb + kt * 4096 + goff), (LAS unsigned*)(KCt + kt * TILE_U + wave * 1024), 16, 0, 0);
        __builtin_amdgcn_global_load_lds((const unsigned*)(vcb + kt * 4096 + goff), (LAS unsigned*)(VCt + kt * TILE_U + wave * 1024), 16, 0, 0); } }
    const bf16_t* prow = PROJ + (size_t)(b * SEQ) * NP;
    bf16x8 qf[2][2];
#pragma unroll
    for (int cb = 0; cb < 2; ++cb)
#pragma unroll
        for (int s = 0; s < 2; ++s) qf[cb][s] = *(const bf16x8*)(prow + (size_t)(tq0 + 4 * cb + tl) * NP + C_QA + head * 64 + 32 * s + 8 * g);
    f32x4 o[2][4]; float m[2], l[2]; FLASH_INIT(o, m, l);
    asm volatile("s_waitcnt vmcnt(0)" ::: "memory");
    __syncthreads();
    for (int kt = 0; kt < nct; ++kt) {
        const int kp0 = kt * 64, dmin = tq0 - (16 * (kp0 + 63) + 31);
        if (kt < 3 && dmin >= 790) flash_tile<2, 2, 2>(KCt + kt * TILE_U, VCt + kt * TILE_U, lbh, qf, o, m, l, tq0, kp0, 0, 0ull, 0ull, 0, 1023, lane);
        else if (kt < 3 && dmin >= 0 && tq0 + 7 - 16 * kp0 - 31 <= 1023) flash_tile<2, 1, 2>(KCt + kt * TILE_U, VCt + kt * TILE_U, lbh, qf, o, m, l, tq0, kp0, 0, 0ull, 0ull, 0, 1023, lane);
        else flash_tile<2, 0, 2>(KCt + kt * TILE_U, VCt + kt * TILE_U, lbh, qf, o, m, l, tq0, kp0, 0, 0ull, 0ull, 0, 1023, lane);
    }
    float invl[2];
    float* const ocl = OCB + (size_t)(u * 8 + wave) * 2048 + lane * 4;
#pragma unroll
    for (int cb = 0; cb < 2; ++cb) { const float lt = quad_sum(l[cb]); invl[cb] = lt > 0.f ? 1.0f / lt : 0.f;
        const size_t row = (size_t)(b * SEQ + tq0 + 4 * cb + tl);
        const float g0 = 1.0f / (1.0f + __expf(-bf2f(PROJ[row * NP + C_GATE + 3 * head])));
#pragma unroll
        for (int c = 0; c < 4; ++c) *(f32x4*)(ocl + cb * 1024 + 256 * c) = o[cb][c] * (invl[cb] * g0);
    }
    __syncthreads();
    float cprev[2] = {0.f, 0.f};
    for (int kt = 0; kt < 4; ++kt) {
        const int kp0c = kt * 64, dminc = tq0 - (16 * (kp0c + 63) + 31);
        const int pth = (kt < 3 && dminc >= 790) ? 2 : ((kt < 3 && dminc >= 0 && tq0 + 7 - 16 * kp0c - 31 <= 1023) ? 1 : 0);
#pragma unroll 1
        for (int kb = 0; kb < 4; ++kb) {
            float own[2] = {0.f, 0.f}, car[2] = {0.f, 0.f};
            if (kt < nct) {
                const LAS unsigned char* kr = KCt + kt * TILE_U + (16 * kb + i16) * 128;
                const bf16x8 a0 = *(const LAS bf16x8*)(kr + ((g ^ (i16 & 7)) << 4)), a1 = *(const LAS bf16x8*)(kr + (((4 + g) ^ (i16 & 7)) << 4));
#pragma unroll
                for (int cb = 0; cb < 2; ++cb) {
                    f32x4 z = {0.f, 0.f, 0.f, 0.f}; z = mfma16(a0, qf[cb][0], z); z = mfma16(a1, qf[cb][1], z);
                    const int tq = tq0 + 4 * cb + tl;
                    if (pth != 0) {
                        f32x4 b4;
                        if (pth == 1) { const LAS float* pb = lbh + (1023 - tq + 31 + 16 * kp0c + 64 * g) + 256 * kb; b4 = (f32x4){pb[0], pb[16], pb[32], pb[48]}; }
                        else { const float bc = lbh[0]; b4 = (f32x4){bc, bc, bc, bc}; }
                        const f32x4 t4 = z * SCL2 + b4; const float mm = m[cb], il = invl[cb];
                        const float p0 = __builtin_amdgcn_exp2f(t4[0] - mm) * il, p1 = __builtin_amdgcn_exp2f(t4[1] - mm) * il, p2 = __builtin_amdgcn_exp2f(t4[2] - mm) * il, p3 = __builtin_amdgcn_exp2f(t4[3] - mm) * il;
                        own[cb] = (p0 + p1) + (p2 + p3); car[cb] = p3;
                    } else {
#pragma unroll
                        for (int r = 0; r < 4; ++r) { const int cc = kt * 64 + 16 * kb + 4 * g + r; const int dist = tq - (16 * cc + 31); const bool valid = dist >= 0 && cc < 255;
                            const float t = z[r] * SCL2 + lbh[1023 - min(max(dist, 0), 1023)];
                            const float pv = valid ? __builtin_amdgcn_exp2f(t - m[cb]) * invl[cb] : 0.f;
                            own[cb] += pv; if (r == 3) car[cb] = pv; }
                    }
                }
            }
#pragma unroll
            for (int cb = 0; cb < 2; ++cb) {
                const float send = (g == 3) ? cprev[cb] : car[cb];
                const float recv = __shfl(send, (lane + 48) & 63);
                cprev[cb] = car[cb];
                IMP[(hl * 64 + 8 * wave + 4 * cb + tl) * 64 + 4 * (4 * kt + kb) + g] = own[cb] + recv;
            }
        }
    }
    __syncthreads();
    for (int tt = 0; tt < 8; ++tt) {
        const int tok = 8 * wave + tt;
        float v = ((IMP[(0 * 64 + tok) * 64 + lane] + IMP[(1 * 64 + tok) * 64 + lane]) + IMP[(2 * 64 + tok) * 64 + lane]) + IMP[(3 * 64 + tok) * 64 + lane];
        const bool forced = lane == 0 || lane == qt || lane == qt - 1;
        v = forced ? v + 1e6f : v; v = lane > qt ? -1e30f : v;
        const unsigned ub = __float_as_uint(v); const unsigned key = (ub & 0x80000000u) ? ~ub : (ub | 0x80000000u);
        unsigned thr = 0u;
#pragma unroll
        for (int bit = 31; bit >= 0; --bit) { const unsigned cand = thr | (1u << bit); if (__popcll(__ballot(key >= cand)) >= 16) thr = cand; }
        const unsigned long long eq = __ballot(key == thr);
        const int need = 16 - __popcll(__ballot(key > thr));
        const int below = __builtin_amdgcn_mbcnt_hi((unsigned)(eq >> 32), __builtin_amdgcn_mbcnt_lo((unsigned)eq, 0u));
        const bool sel = key > thr || (key == thr && below < need);
        const unsigned long long mk = __ballot(sel && lane <= qt);
        if (lane == 0) MASK[tok] = mk;
    }
    __syncthreads();
    unsigned long long um = MASK[lane];
    { unsigned lo = (unsigned)um, hi = (unsigned)(um >> 32);
#pragma unroll
      for (int off = 1; off < 64; off <<= 1) { lo |= __shfl_xor(lo, off); hi |= __shfl_xor(hi, off); }
      lo = __builtin_amdgcn_readfirstlane(lo); hi = __builtin_amdgcn_readfirstlane(hi); um = ((unsigned long long)hi << 32) | lo; }
    const unsigned long long mk0 = MASK[8 * wave + tl], mk1 = MASK[8 * wave + 4 + tl];
    const unsigned long long um_all = um;
    for (int rs_ = 0; rs_ < REP_SEL; ++rs_) {
    um = um_all; FLASH_INIT(o, m, l);
    {
        const bf16_t* kbase = prow + C_KS + kvh * 64; const bf16_t* vbase = prow + C_VS + kvh * 64;
        LAS unsigned char* ring = KCt;
        unsigned long long ui = um;
        const int nt = __builtin_popcountll(um);
        asm volatile("s_waitcnt vmcnt(0)" ::: "memory");
        for (int p = 0; p < 2 && p < nt; ++p) { const int jj = __builtin_ctzll(ui); ui &= ui - 1ull; dma_tile(ring + p * 2 * TILE_U, kbase + (size_t)(64 * jj) * NP, vbase + (size_t)(64 * jj) * NP, NP, lane, wave); }
        for (int i = 0; i < nt; i += 2) {
            RING_PAIR_BARRIER();
            for (int h = 2; h < 4; ++h) if (ui) { const int jj = __builtin_ctzll(ui); ui &= ui - 1ull; dma_tile(ring + ((i + h) & 3) * 2 * TILE_U, kbase + (size_t)(64 * jj) * NP, vbase + (size_t)(64 * jj) * NP, NP, lane, wave); }
#pragma unroll 1
            for (int h = 0; h < 2; ++h) { if (i + h >= nt) break;
                const int j = __builtin_ctzll(um); um &= um - 1ull;
                const LAS unsigned char* Kt = ring + ((i + h) & 3) * 2 * TILE_U; const int kp0 = 64 * j;
                if (tq0 - (kp0 + 63) >= 790) flash_tile<1, 2, 2>(Kt, Kt + TILE_U, lbh, qf, o, m, l, tq0, kp0, 0, mk0, mk1, j, 1023, lane);
                else if (kp0 + 63 <= tq0 && tq0 + 7 - kp0 <= 1023) flash_tile<1, 1, 2>(Kt, Kt + TILE_U, lbh, qf, o, m, l, tq0, kp0, 0, mk0, mk1, j, 1023, lane);
                else flash_tile<1, 0, 2>(Kt, Kt + TILE_U, lbh, qf, o, m, l, tq0, kp0, 0, mk0, mk1, j, 1023, lane); }
        }
    }
    }
    __syncthreads();
    LAS float* scr = (LAS float*)(KCt + wave * F2R_BYTES);
#pragma unroll
    for (int cb = 0; cb < 2; ++cb) {
        const size_t row = (size_t)(b * SEQ + tq0 + 4 * cb + tl);
        const bf16_t* gp = PROJ + row * NP + C_GATE + 3 * head;
        const float g1 = 1.0f / (1.0f + __expf(-bf2f(gp[1]))), g2 = 1.0f / (1.0f + __expf(-bf2f(gp[2])));
        const float lt = quad_sum(l[cb]); const float inv = (lt > 0.f ? 1.0f / lt : 0.f) * g1;
        f32x4 v[4], t[4];
#pragma unroll
        for (int c = 0; c < 4; ++c) v[c] = *(const f32x4*)(ocl + cb * 1024 + 256 * c) + o[cb][c] * inv;
        frag_to_rows(v, t, scr, i16, g);
        const bf16_t* wp = OW + row * 1024 + head * 64 + 16 * g;
        const u32x4 wa = *(const u32x4*)wp, wb = *(const u32x4*)(wp + 8);
        const unsigned wu[8] = {wa.x, wa.y, wa.z, wa.w, wb.x, wb.y, wb.z, wb.w};
#pragma unroll
        for (int q = 0; q < 4; ++q) { t[q][0] += g2 * __uint_as_float(wu[2 * q] << 16); t[q][1] += g2 * __uint_as_float(wu[2 * q] & 0xffff0000u);
            t[q][2] += g2 * __uint_as_float(wu[2 * q + 1] << 16); t[q][3] += g2 * __uint_as_float(wu[2 * q + 1] & 0xffff0000u); }
        store_row16_bf16(AO + row * DM + head * 64 + 16 * g, t);
    }
}

#define RLX_AGENT __ATOMIC_RELAXED, __HIP_MEMORY_SCOPE_AGENT
#define XB_TMO      128
#define XB_XCNT(j)  (256  + 64 * (j))
#define XB_XSUB(j)  (1280 + 64 * (j))
#define XB_XGEN(j)  (2304 + 64 * (j))
#define XB_TOP      3328
#define XB_TOPGEN   3392
#define XCD_BAR_WORDS 3456
#define XB_SPIN_CAP (1u << 18)

__device__ __forceinline__ unsigned xb_ld(unsigned* p)              { return __hip_atomic_load(p, __ATOMIC_RELAXED, __HIP_MEMORY_SCOPE_AGENT); }
__device__ __forceinline__ unsigned xb_add(unsigned* p, unsigned v) { return __hip_atomic_fetch_add(p, v, __ATOMIC_RELAXED, __HIP_MEMORY_SCOPE_AGENT); }
__device__ __forceinline__ unsigned xb_xcc_id() { return (unsigned)__builtin_amdgcn_s_getreg((3 << 11) | 20) & 0xFu; }
#define XB_SPIN(cond, bar) do { unsigned _sp = 0; while (cond) { __builtin_amdgcn_s_sleep(1); \
    if ((++_sp & 255u) == 0u) { if (xb_ld(&(bar)[XB_TMO])) break; if (_sp > XB_SPIN_CAP) { atomicAdd(&(bar)[XB_TMO], 1u); break; } } } } while (0)

struct XcdBarrier {
    unsigned* bar; unsigned x;
    volatile LAS unsigned* st;
};

__device__ __forceinline__ XcdBarrier xcd_barrier_post(unsigned* bar, volatile LAS unsigned* st) {
    XcdBarrier b; b.bar = bar; b.x = xb_xcc_id(); b.st = st;
    if (threadIdx.x == 0) (void)xb_add(&bar[XB_XCNT(b.x)], 1u);
    return b;
}
__device__ __forceinline__ void xcd_barrier_complete(unsigned* bar, unsigned x, unsigned& nloc, unsigned& nx) {
    const unsigned G = gridDim.x * gridDim.y * gridDim.z;
    unsigned sum, cnt, mine, sp = 0u;
    for (;;) {
        sum = 0u; cnt = 0u; mine = 0u;
#pragma unroll
        for (unsigned j = 0; j < 16; ++j) { const unsigned c = xb_ld(&bar[XB_XCNT(j)]); sum += c; cnt += (c > 0u) ? 1u : 0u; mine = (j == x) ? c : mine; }
        if (sum == G) break;
        __builtin_amdgcn_s_sleep(1);
        if ((++sp & 255u) == 0u) { if (xb_ld(&bar[XB_TMO])) break; if (sp > XB_SPIN_CAP) { atomicAdd(&bar[XB_TMO], 1u); break; } }
    }
    nloc = mine > 0u ? mine : 1u; nx = cnt > 0u ? cnt : 1u;
}

__device__ __forceinline__ void xcd_barrier(const XcdBarrier& b) {
    asm volatile("s_waitcnt vmcnt(0)" ::: "memory");
    __syncthreads();
    if (threadIdx.x == 0) {
        unsigned* bar = b.bar;
        __builtin_amdgcn_s_waitcnt(0);
        unsigned nloc = b.st[0], nx = b.st[1];
        if (nloc == 0u) { xcd_barrier_complete(bar, b.x, nloc, nx); b.st[0] = nloc; b.st[1] = nx; }
        const unsigned old = xb_add(&bar[XB_XSUB(b.x)], 1u);
        const unsigned gen = old / nloc;
        if (old + 1u == (gen + 1u) * nloc) {
            __builtin_amdgcn_fence(__ATOMIC_RELEASE, "agent");
            asm volatile("s_waitcnt vmcnt(0)" ::: "memory");
            const unsigned og = xb_add(&bar[XB_TOP], 1u);
            const unsigned tg = og / nx;
            if (og + 1u == (tg + 1u) * nx) xb_add(&bar[XB_TOPGEN], 1u);
            else XB_SPIN(xb_ld(&bar[XB_TOPGEN]) == tg, bar);
            __builtin_amdgcn_fence(__ATOMIC_ACQUIRE, "agent");
            xb_add(&bar[XB_XGEN(b.x)], 1u);
            asm volatile("s_waitcnt vmcnt(0)" ::: "memory");
        } else {
            XB_SPIN(xb_ld(&bar[XB_XGEN(b.x)]) == gen, bar);
            __builtin_amdgcn_fence(__ATOMIC_ACQUIRE, "agent");
            asm volatile("s_waitcnt vmcnt(0)" ::: "memory");
        }
    }
    __syncthreads();
}

constexpr int REP_A = 1, REP_C = 1, REP_D = 1, REP_G = 1, REP_S = 0;
#define PHASE_BEGIN \
    PP Pp = (PP)__builtin_amdgcn_kernarg_segment_ptr(); asm volatile("" : "+s"(Pp)); \
    int tid_ = threadIdx.x; asm volatile("" : "+v"(tid_)); \
    const int tid = tid_, lane = tid & 63, wave = __builtin_amdgcn_readfirstlane(tid >> 6), gw = bx * 8 + wave; (void)gw; (void)lane; \
    unsigned char* const ws = Pp->ws; (void)ws

__global__ void __launch_bounds__(512, 2) mega_fwd(Params P_unused) {
    extern __shared__ __attribute__((aligned(16))) unsigned char lds_raw[];
    LAS unsigned char* lds = (LAS unsigned char*)lds_raw;
    cg::grid_group grid = cg::this_grid();
    const int G = gridDim.x, bx = blockIdx.x, ngw = G * 8;
    { volatile LAS unsigned* st0 = (volatile LAS unsigned*)(lds + MISC_OFF); if (threadIdx.x < 2) st0[threadIdx.x] = 0u; }
    if (bx == 0) { PP Pq = (PP)__builtin_amdgcn_kernarg_segment_ptr(); unsigned* bw = (unsigned*)(Pq->ws + WS_BAR); for (int i = threadIdx.x; i < XCD_BAR_WORDS; i += 512) bw[i] = 0u; }
    __syncthreads();
    XcdBarrier xbar; xbar.bar = nullptr; xbar.x = 0u; xbar.st = nullptr;
#define GRID_SYNC() xcd_barrier(xbar)

    { PHASE_BEGIN; prep_phase(Pp, 0, lds, gw, ngw, tid, lane, wave);
      rows_bf16_ssq(Pp->in[0], Pp->in[2], (bf16_t*)(ws + WS_XN), (float*)(ws + WS_SSQ), gw, ngw, lane); }
    grid.sync();
    { PP Pq = (PP)__builtin_amdgcn_kernarg_segment_ptr(); xbar = xcd_barrier_post((unsigned*)(Pq->ws + WS_BAR), (volatile LAS unsigned*)(lds + MISC_OFF)); }
    for (int L = 0; L < DEPTH; ++L) {
#if !defined(ONLY) || ONLY == 1
        { PHASE_BEGIN;
          pg8::Gemm gm{(const bf16_t*)(ws + WS_XN), (const bf16_t*)(ws + WS_WIN), MTOK, NP, DM}; pg8::StaticOrder S; S.init(MTOK, NP, G, bx);
          pg8::EpiProjN E{0};
          pg8::gemm_phase<pg8::EpiProjN, pg8::StaticOrder, true, true>(lds, gm, S, E); }
#endif
        GRID_SYNC();
#if !defined(ONLY) || ONLY == 2
        for (int rep_ = 0; rep_ < REP_C; ++rep_) {
        { PHASE_BEGIN;
          const bf16_t* PROJ = (const bf16_t*)(ws + WS_PROJ); const float* BT = (const float*)(ws + WS_BT);
          for (int it = bx; it < 1280; it += G) {
            int kind, uu;
            if (G == 256) { const int k = it >> 8, x = bx & 7, loc = bx >> 3;
                if (k == 0) { kind = 0; uu = ((loc >> 4) << 7) | (x * 16 + (loc & 15)); }
                else if (k <= 2) { kind = 1; uu = x * 64 + (k == 1 ? loc : 63 - loc); }
                else { kind = 2; uu = (x >> 1) * 128 + (x & 1) * 64 + (k == 3 ? loc : 63 - loc); } }
            else { kind = it < 256 ? 0 : (it < 768 ? 1 : 2); uu = it - (kind == 0 ? 0 : (kind == 1 ? 256 : 768)); }
            if (kind == 1) nsaw_unit(uu, PROJ, BT, (bf16_t*)(ws + WS_OW), lds, tid, lane, wave);
            else if (kind == 2) swa_unit(uu, PROJ, BT, Pp->in[12] + L * 16, (bf16_t*)(ws + WS_AO), lds, tid, lane, wave);
            else { const int cu = uu; const int mat = cu >> 7;
                compress_unit(cu & 127, PROJ, mat ? C_VC : C_KC, (const bf16_t*)(ws + (mat ? WS_C1V : WS_C1K)), (const bf16_t*)(ws + (mat ? WS_C2V : WS_C2K)),
                              (const float*)(ws + WS_CBP) + mat * 8192, (bf16_t*)(ws + (mat ? WS_VC : WS_KC)), lds, tid, lane, wave); }
          } }
        GRID_SYNC(); }
#endif
#if !defined(ONLY) || ONLY == 3
        for (int rep_ = 0; rep_ < REP_D; ++rep_) {
        { PHASE_BEGIN;
          for (int it = bx; it < 512; it += G) { const int u = G == 256 ? (bx & 7) * 64 + (it < 256 ? (bx >> 3) : 63 - (bx >> 3)) : (it < 256 ? it : 767 - it);
            nsa_unit(u, (const bf16_t*)(ws + WS_PROJ), (const float*)(ws + WS_BT), (const bf16_t*)(ws + WS_KC), (const bf16_t*)(ws + WS_VC), (const bf16_t*)(ws + WS_OW),
                     (float*)(ws + WS_OCB), (bf16_t*)(ws + WS_AO), lds, tid, lane, wave); } }
        GRID_SYNC(); }
#endif
        for (int rep_ = 0; rep_ < REP_S; ++rep_) GRID_SYNC();
#if !defined(ONLY) || ONLY == 4
        { PHASE_BEGIN;
          pg8::Gemm gm{(const bf16_t*)(ws + WS_AO), (const bf16_t*)(ws + WS_WOUT), MTOK, DM, DM}; pg8::StaticOrder S; S.init(MTOK, DM, G, bx);
          pg8::EpiResid E{L == 0, 3, L};
          pg8::gemm_phase<pg8::EpiResid, pg8::StaticOrder, true, true>(lds, gm, S, E); }
#endif
        GRID_SYNC();
#if !defined(ONLY) || ONLY == 6
        for (int rep_ = 0; rep_ < REP_G; ++rep_) {
        { PHASE_BEGIN;
          pg8::Gemm gm{(const bf16_t*)(ws + WS_XN), (const bf16_t*)(ws + ((L & 1) ? WS_WGU_B : WS_WGU)), MTOK, NGU, DM}; pg8::StaticOrder S; S.init(MTOK, NGU, G, bx);
          pg8::EpiSwiGLU E{0};
          pg8::gemm_phase<pg8::EpiSwiGLU, pg8::StaticOrder, true, true>(lds, gm, S, E);
          if (L + 1 < DEPTH && G == 256 && bx >= 128) { PHASE_BEGIN; prep_phase(Pp, L + 1, lds, (bx - 128) * 8 + wave, 128 * 8, tid, lane, wave, 0, PREP_EARLY, false); } }
        GRID_SYNC(); }
#endif
#if !defined(ONLY) || ONLY == 7
        { PHASE_BEGIN;
          pg8::Gemm gm{(const bf16_t*)(ws + WS_ACT), (const bf16_t*)(ws + ((L & 1) ? WS_WDN_B : WS_WDN)), MTOK, DM, DFF}; pg8::StaticOrder S; S.init(MTOK, DM, G, bx);
          pg8::EpiResid E{0, L == DEPTH - 1 ? 17 : 2, L == DEPTH - 1 ? 0 : L + 1, L == DEPTH - 1};
          pg8::gemm_phase<pg8::EpiResid, pg8::StaticOrder, true, true>(lds, gm, S, E);
          if (L + 1 < DEPTH) { PHASE_BEGIN; prep_phase(Pp, L + 1, lds, gw, ngw, tid, lane, wave, G == 256 ? PREP_EARLY : 0, PREP_NITEMS, true); } }
#endif
        GRID_SYNC();
    }
    { PHASE_BEGIN; norm_rows_f32((const float*)(ws + WS_X), Pp->in[17], Pp->out, gw, ngw, lane); }
}

extern "C" void kernel_launch(void* const* d_in, const int* in_sizes, int n_in, void* d_out, int out_size, void* d_ws, size_t ws_size, hipStream_t stream) {
    static int grid = 0;
    if (grid == 0) {
        if (n_in != 18 || ws_size < WS_END) { fprintf(stderr, "kernel_launch: unexpected n_in %d / ws_size %zu\n", n_in, ws_size); grid = -1; return; }
        int dev = 0, cus = 0, per_cu = 0;
        (void)hipGetDevice(&dev); (void)hipDeviceGetAttribute(&cus, hipDeviceAttributeMultiprocessorCount, dev);
        if (hipFuncSetAttribute((const void*)mega_fwd, hipFuncAttributeMaxDynamicSharedMemorySize, LDS_BYTES) != hipSuccess) fprintf(stderr, "kernel_launch: hipFuncSetAttribute failed\n");
        if (hipOccupancyMaxActiveBlocksPerMultiprocessor(&per_cu, (const void*)mega_fwd, 512, LDS_BYTES) != hipSuccess || per_cu < 1) { fprintf(stderr, "kernel_launch: occupancy query gave %d\n", per_cu); per_cu = 1; }
        (void)hipGetLastError();
        grid = cus * per_cu;
    }
    if (grid < 0) return;
    Params p{};
    for (int i = 0; i < 18; ++i) p.in[i] = (const float*)d_in[i];
    p.out = (float*)d_out; p.ws = (unsigned char*)d_ws;
    void* args[] = {&p};
    const hipError_t e = hipLaunchCooperativeKernel((const void*)mega_fwd, dim3(grid), dim3(512), args, LDS_BYTES, stream);
    if (e != hipSuccess) fprintf(stderr, "kernel_launch: cooperative launch failed: %s (grid %d)\n", hipGetErrorString(e), grid);
}
```
